# Optimizing an MI355X kernel written in HIP

```python
import math
import jax, jax.numpy as jnp
from jax import lax
import numpy as np

D_MODEL = 1024
BATCH = 8
SEQ = 8192
DEPTH = 4
DEC_BATCH = 8
DEC_SEQ = 16
PAST_LEN = 4096

CHUNK = 64
D_FF = 2816
EPS = 1e-6
POOL_W = D_MODEL // 2
POOL_GROUPS = 4
POOL_GC = POOL_W // POOL_GROUPS
POOL_WINDOWS = (2, 4, 8, 16)
POOL_HIST = 15
SSM_INNER = D_MODEL
SSM_HEADDIM = 64
SSM_HEADS = SSM_INNER // SSM_HEADDIM
SSM_GROUPS = 4
SSM_STATE = 128
SSM_CONV = 4
XBC_W = SSM_INNER + 2 * SSM_GROUPS * SSM_STATE
GMLP_W = D_MODEL // 2
GMLP_HEADS = 4
GMLP_HC = GMLP_W // GMLP_HEADS
GMLP_CHUNK = 128
N_BRANCH = 3
IN_COLS = POOL_W + SSM_INNER + XBC_W + SSM_HEADS + 2 * GMLP_W + N_BRANCH * D_MODEL

kernel_name = 'hybrid_streaming_encoder_step'


def rms_norm(x, g):
    xf = x.astype(jnp.float32)
    y = xf * lax.rsqrt(jnp.mean(xf * xf, axis=-1, keepdims=True) + EPS)
    return (y * g.astype(jnp.float32)).astype(x.dtype)


def layer_norm(x, g, b):
    xf = x.astype(jnp.float32)
    mu = jnp.mean(xf, axis=-1, keepdims=True)
    xc = xf - mu
    y = xc * lax.rsqrt(jnp.mean(xc * xc, axis=-1, keepdims=True) + EPS)
    return (y * g.astype(jnp.float32) + b.astype(jnp.float32)).astype(x.dtype)


def swiglu(x, w_gu, w_down):
    gate, up = jnp.split(x @ w_gu, 2, axis=-1)
    return (jax.nn.silu(gate) * up) @ w_down


def causal_dwconv(x, hist, w, b):
    L = x.shape[1]
    xp = jnp.concatenate([hist, x], axis=1)
    out = b + w[0] * xp[:, 0:L]
    for k in range(1, SSM_CONV):
        out = out + w[k] * xp[:, k:k + L]
    return out, xp[:, L:]


def pool_mixer(xa, hist, pos0, pool_w, pool_scale):
    b, L, C = xa.shape
    ext = jnp.concatenate([hist, xa], axis=1)
    cs = jnp.cumsum(ext.astype(jnp.float32), axis=1)
    cs = jnp.concatenate([jnp.zeros_like(cs[:, :1]), cs], axis=1)
    off = POOL_HIST + 1
    pos = pos0 + jnp.arange(L)
    means = []
    for gi, w in enumerate(POOL_WINDOWS):
        sl = slice(gi * POOL_GC, (gi + 1) * POOL_GC)
        s = cs[:, off:, sl] - cs[:, off - w:off - w + L, sl]
        cnt = jnp.minimum(pos + 1, w).astype(jnp.float32)[None, :, None]
        means.append(s / cnt)
    mean = jnp.concatenate(means, axis=-1).astype(xa.dtype)
    zz = (mean - xa).reshape(b, L, POOL_GROUPS, POOL_GC)
    y = jnp.einsum('blgc,gcd->blgd', zz, pool_w).reshape(b, L, C) * pool_scale
    return y, ext[:, L:]


def ssd_scan(x, dt, a, bm, cm, s0, blk):
    b, L, H, P = x.shape
    G, N = bm.shape[2], bm.shape[3]
    R = H // G
    nc = L // blk
    f32 = jnp.float32
    xf = x.astype(f32).reshape(b, nc, blk, G, R, P)
    dtf = dt.astype(f32).reshape(b, nc, blk, G, R)
    bf = bm.astype(f32).reshape(b, nc, blk, G, N)
    cf = cm.astype(f32).reshape(b, nc, blk, G, N)
    cum = jnp.cumsum(dtf * a.reshape(G, R), axis=2)
    cum_t = jnp.moveaxis(cum, 2, -1)
    mask = jnp.tril(jnp.ones((blk, blk), dtype=bool))
    decay = jnp.exp(jnp.where(mask, cum_t[..., :, None] - cum_t[..., None, :], -jnp.inf))
    cb = jnp.einsum('bclgn,bcsgn->bcgls', cf, bf)
    mmat = cb[:, :, :, None] * decay * jnp.moveaxis(dtf, 2, -1)[..., None, :]
    y_diag = jnp.einsum('bcgrls,bcsgrp->bclgrp', mmat, xf)
    last = cum[:, :, -1]
    xw = xf * (jnp.exp(last[:, :, None] - cum) * dtf)[..., None]
    chunk_states = jnp.einsum('bclgn,bclgrp->bcgrpn', bf, xw)

    def step(s, inp):
        dec, st = inp
        return s * dec[..., None, None] + st, s

    s_fin, s_in = lax.scan(step, s0.astype(f32).reshape(b, G, R, P, N),
                           (jnp.moveaxis(jnp.exp(last), 1, 0), jnp.moveaxis(chunk_states, 1, 0)))
    s_in = jnp.moveaxis(s_in, 0, 1)
    y_off = jnp.einsum('bclgn,bcgrpn->bclgrp', cf, s_in) * jnp.exp(cum)[..., None]
    y = (y_diag + y_off).reshape(b, L, H, P).astype(x.dtype)
    return y, s_fin.reshape(b, H, P, N).astype(s0.dtype)


def spatial_gate(u, vn, ws, bs):
    b, L, C = vn.shape
    blk = min(L, GMLP_CHUNK)
    n = L // blk
    mask = jnp.tril(jnp.ones((blk, blk), dtype=bool))
    wsm = jnp.where(mask, ws[:, :blk, :blk], 0.0).astype(vn.dtype)
    vh = vn.reshape(b, n, blk, GMLP_HEADS, GMLP_HC)
    sv = jnp.einsum('hts,bnshc->bnthc', wsm, vh) + bs[:, :blk].T[:, :, None].astype(vn.dtype)
    return u * sv.reshape(b, L, C)


def mixer(xn, hist_pool, hist_conv, s0, pos0, w_in, pool_w, pool_scale, conv_w, conv_b, dt_bias,
          a_log, d_skip, norm_g, gn_g, gn_b, ws, bs, wa, wb, wc, wo):
    b, L, _ = xn.shape
    proj = xn @ w_in
    cuts = np.cumsum([POOL_W, SSM_INNER, XBC_W, SSM_HEADS, GMLP_W, GMLP_W]).tolist()
    xa, z, xbc, dt_raw, u, v, gate_cols = jnp.split(proj, cuts, axis=-1)
    ya, new_pool = pool_mixer(xa, hist_pool, pos0, pool_w, pool_scale)
    xbc, new_conv = causal_dwconv(xbc, hist_conv, conv_w, conv_b)
    xbc = jax.nn.silu(xbc)
    xs, bm, cm = jnp.split(xbc, [SSM_INNER, SSM_INNER + SSM_GROUPS * SSM_STATE], axis=-1)
    xs = xs.reshape(b, L, SSM_HEADS, SSM_HEADDIM)
    bm = bm.reshape(b, L, SSM_GROUPS, SSM_STATE)
    cm = cm.reshape(b, L, SSM_GROUPS, SSM_STATE)
    dt = jax.nn.softplus(dt_raw.astype(jnp.float32) + dt_bias.astype(jnp.float32))
    a = -jnp.exp(a_log.astype(jnp.float32))
    y, new_ssm = ssd_scan(xs, dt, a, bm, cm, s0, min(L, CHUNK))
    y = y + d_skip[:, None].astype(y.dtype) * xs
    yb = rms_norm(y.reshape(b, L, SSM_INNER) * jax.nn.silu(z), norm_g)
    vn = layer_norm(v, gn_g, gn_b)
    yc = spatial_gate(u, vn, ws, bs)
    gates = jax.nn.sigmoid(gate_cols.astype(jnp.float32)).astype(xn.dtype).reshape(b, L, N_BRANCH, D_MODEL)
    merged = gates[:, :, 0] * (ya @ wa) + gates[:, :, 1] * (yb @ wb) + gates[:, :, 2] * (yc @ wc)
    return merged @ wo, new_pool, new_conv, new_ssm, vn


def run_trunk(x, pool_st, conv_st, ssm_st, pos0,
              ffn1_pre_g, ffn1_post_g, ffn1_w_gu, ffn1_w_down,
              mix_pre_g, mix_post_g, w_in, pool_w, pool_scale,
              ssm_conv_w, ssm_conv_b, ssm_dt_bias, ssm_a_log, ssm_d, ssm_norm_g,
              gmlp_norm_g, gmlp_norm_b, gmlp_ws, gmlp_bs,
              w_branch_a, w_branch_b, w_branch_c, w_out,
              ffn2_pre_g, ffn2_post_g, ffn2_w_gu, ffn2_w_down):
    new_pool, new_conv, new_ssm, new_v = [], [], [], []
    h = x
    for l in range(DEPTH):
        f = swiglu(rms_norm(h, ffn1_pre_g[l]), ffn1_w_gu[l], ffn1_w_down[l])
        h = h + 0.5 * rms_norm(f, ffn1_post_g[l])
        m, ps, cs, ss, vn = mixer(rms_norm(h, mix_pre_g[l]), pool_st[l], conv_st[l], ssm_st[l], pos0,
                                  w_in[l], pool_w[l], pool_scale[l], ssm_conv_w[l], ssm_conv_b[l],
                                  ssm_dt_bias[l], ssm_a_log[l], ssm_d[l], ssm_norm_g[l],
                                  gmlp_norm_g[l], gmlp_norm_b[l], gmlp_ws[l], gmlp_bs[l],
                                  w_branch_a[l], w_branch_b[l], w_branch_c[l], w_out[l])
        h = h + rms_norm(m, mix_post_g[l])
        f = swiglu(rms_norm(h, ffn2_pre_g[l]), ffn2_w_gu[l], ffn2_w_down[l])
        h = h + 0.5 * rms_norm(f, ffn2_post_g[l])
        new_pool.append(ps)
        new_conv.append(cs)
        new_ssm.append(ss)
        new_v.append(vn)
    return h, jnp.stack(new_pool), jnp.stack(new_conv), jnp.stack(new_ssm), new_v


def setup_inputs(seed: int = 0) -> dict:
    key = jax.random.key(seed)
    ks = jax.random.split(key, 32)
    f32 = jnp.float32

    def nrm(k, shape, scale):
        return scale * jax.random.normal(k, shape, f32)

    def gain(k, shape):
        return 1.0 + 0.05 * jax.random.normal(k, shape, f32)

    dt0 = jnp.exp(jax.random.uniform(ks[16], (DEPTH, SSM_HEADS), f32, math.log(1e-3), math.log(1e-1)))
    return {
        'x_prompt': nrm(ks[0], (BATCH, SEQ, D_MODEL), 1.0),
        'x_sample': nrm(ks[1], (DEC_BATCH, DEC_SEQ, D_MODEL), 1.0),
        'state_pool': nrm(ks[2], (DEPTH, DEC_BATCH, POOL_HIST, POOL_W), 1.0),
        'state_conv': nrm(ks[3], (DEPTH, DEC_BATCH, SSM_CONV - 1, XBC_W), 1.0),
        'state_ssm': nrm(ks[4], (DEPTH, DEC_BATCH, SSM_HEADS, SSM_HEADDIM, SSM_STATE), 0.5),
        'ffn1_pre_g': gain(ks[5], (DEPTH, D_MODEL)),
        'ffn1_post_g': gain(ks[6], (DEPTH, D_MODEL)),
        'ffn1_w_gu': nrm(ks[7], (DEPTH, D_MODEL, 2 * D_FF), D_MODEL ** -0.5),
        'ffn1_w_down': nrm(ks[8], (DEPTH, D_FF, D_MODEL), D_FF ** -0.5),
        'mix_pre_g': gain(ks[9], (DEPTH, D_MODEL)),
        'mix_post_g': gain(ks[10], (DEPTH, D_MODEL)),
        'w_in': nrm(ks[11], (DEPTH, D_MODEL, IN_COLS), D_MODEL ** -0.5),
        'pool_w': nrm(ks[12], (DEPTH, POOL_GROUPS, POOL_GC, POOL_GC), POOL_GC ** -0.5),
        'pool_scale': gain(ks[13], (DEPTH, POOL_W)),
        'ssm_conv_w': nrm(ks[14], (DEPTH, SSM_CONV, XBC_W), SSM_CONV ** -0.5),
        'ssm_conv_b': nrm(ks[15], (DEPTH, XBC_W), 0.01),
        'ssm_dt_bias': dt0 + jnp.log(-jnp.expm1(-dt0)),
        'ssm_a_log': jnp.log(jax.random.uniform(ks[17], (DEPTH, SSM_HEADS), f32, 1.0, 16.0)),
        'ssm_d': gain(ks[18], (DEPTH, SSM_HEADS)),
        'ssm_norm_g': gain(ks[19], (DEPTH, SSM_INNER)),
        'gmlp_norm_g': gain(ks[20], (DEPTH, GMLP_W)),
        'gmlp_norm_b': nrm(ks[21], (DEPTH, GMLP_W), 0.01),
        'gmlp_ws': nrm(ks[22], (DEPTH, GMLP_HEADS, GMLP_CHUNK, GMLP_CHUNK), GMLP_CHUNK ** -0.5),
        'gmlp_bs': gain(ks[23], (DEPTH, GMLP_HEADS, GMLP_CHUNK)),
        'w_branch_a': nrm(ks[24], (DEPTH, POOL_W, D_MODEL), POOL_W ** -0.5),
        'w_branch_b': nrm(ks[25], (DEPTH, SSM_INNER, D_MODEL), SSM_INNER ** -0.5),
        'w_branch_c': nrm(ks[26], (DEPTH, GMLP_W, D_MODEL), GMLP_W ** -0.5),
        'w_out': nrm(ks[27], (DEPTH, D_MODEL, D_MODEL), D_MODEL ** -0.5),
        'ffn2_pre_g': gain(ks[28], (DEPTH, D_MODEL)),
        'ffn2_post_g': gain(ks[29], (DEPTH, D_MODEL)),
        'ffn2_w_gu': nrm(ks[30], (DEPTH, D_MODEL, 2 * D_FF), D_MODEL ** -0.5),
        'ffn2_w_down': nrm(ks[31], (DEPTH, D_FF, D_MODEL), D_FF ** -0.5),
    }


def reference(x_prompt, x_sample, state_pool, state_conv, state_ssm,
              ffn1_pre_g, ffn1_post_g, ffn1_w_gu, ffn1_w_down,
              mix_pre_g, mix_post_g, w_in, pool_w, pool_scale,
              ssm_conv_w, ssm_conv_b, ssm_dt_bias, ssm_a_log, ssm_d, ssm_norm_g,
              gmlp_norm_g, gmlp_norm_b, gmlp_ws, gmlp_bs,
              w_branch_a, w_branch_b, w_branch_c, w_out,
              ffn2_pre_g, ffn2_post_g, ffn2_w_gu, ffn2_w_down):
    weights = (ffn1_pre_g, ffn1_post_g, ffn1_w_gu, ffn1_w_down,
               mix_pre_g, mix_post_g, w_in, pool_w, pool_scale,
               ssm_conv_w, ssm_conv_b, ssm_dt_bias, ssm_a_log, ssm_d, ssm_norm_g,
               gmlp_norm_g, gmlp_norm_b, gmlp_ws, gmlp_bs,
               w_branch_a, w_branch_b, w_branch_c, w_out,
               ffn2_pre_g, ffn2_post_g, ffn2_w_gu, ffn2_w_down)
    bp = x_prompt.shape[0]
    zero_pool = jnp.zeros((DEPTH, bp, POOL_HIST, POOL_W), x_prompt.dtype)
    zero_conv = jnp.zeros((DEPTH, bp, SSM_CONV - 1, XBC_W), x_prompt.dtype)
    zero_ssm = jnp.zeros((DEPTH, bp, SSM_HEADS, SSM_HEADDIM, SSM_STATE), x_prompt.dtype)
    y_prompt, pool_p, conv_p, ssm_p, _ = run_trunk(x_prompt, zero_pool, zero_conv, zero_ssm, 0, *weights)
    y_sample, pool_s, conv_s, ssm_s, v_rows = run_trunk(x_sample, state_pool, state_conv, state_ssm, PAST_LEN, *weights)
    gmlp_v_s = jnp.stack(v_rows)
    return (y_prompt, y_sample, pool_p, conv_p, ssm_p, pool_s, conv_s, ssm_s, gmlp_v_s)
```

```cpp
#include <hip/hip_runtime.h>
#include <hip/hip_cooperative_groups.h>
#include <cstdio>
namespace cg = cooperative_groups;

namespace pg8 {
#define PG8_LAS __attribute__((address_space(3)))
typedef unsigned short bf16_t;
typedef short bf16x8 __attribute__((ext_vector_type(8)));
typedef float f32x4 __attribute__((ext_vector_type(4)));
typedef unsigned u32x4 __attribute__((ext_vector_type(4)));
constexpr int BM = 256, BK = 64, HALF = 128, HTB = HALF * BK * 2  , STAGE_BYTES = 8 * HTB, NXCD = 8, WGM = 4;

__host__ __device__ __forceinline__ int lds_byte(int r, int c) { const int st = (r >> 4) * 2 + (c >> 5), rr = r & 15, cc = c & 31, ob = rr * 64 + cc * 2; return st * 1024 + (ob ^ (((ob >> 9) & 1) << 5)); }
__host__ __device__ __forceinline__ void stage_rc(int b, int& R, int& C) { const int st = b / 1024, sb = b % 1024, swz = sb ^ (((sb >> 9) & 1) << 5); R = (st >> 1) * 16 + swz / 64; C = (st & 1) * 32 + (swz % 64) / 2; }
__host__ __device__ __forceinline__ int perm32(int rho) { const int n = rho >> 4, i = rho & 15; return 8 * (i >> 2) + 4 * n + (i & 3); }

struct Unit { int pm, pn; };
struct Gemm { const bf16_t* A; const bf16_t* Bt; int M, N, K; };

struct StaticOrder {
    int nM, nN, nwg, G, c;
    __host__ __device__ void init(int M, int N, int G_, int c_) { nM = M / BM; nN = N / BM; nwg = nM * nN; G = G_; c = c_; }
    __host__ __device__ bool next(int i, Unit& u) const {
        const long L = (long)i * G + c; if (L >= nwg) return false;
        int wgid = (int)L; { const int q = nwg / NXCD, r = nwg % NXCD, xcd = wgid % NXCD, off = wgid / NXCD; wgid = (xcd < r ? xcd * (q + 1) : r * (q + 1) + (xcd - r) * q) + off; }
        const int nig = WGM * nN, gid = wgid / nig, fm = gid * WGM, gsz = (nM - fm) < WGM ? (nM - fm) : WGM;
        u.pm = fm + ((wgid % nig) % gsz); u.pn = (wgid % nig) / gsz; return true;
    }
    __device__ __forceinline__ void a_ready(const Unit&) const {}
    __device__ __forceinline__ void done(const Unit&) const {}
};

__device__ __forceinline__ unsigned cvt_pk_bf16(float lo, float hi) { unsigned r; asm volatile("v_cvt_pk_bf16_f32 %0, %1, %2" : "=v"(r) : "v"(lo), "v"(hi)); return r; }
typedef float f32x2 __attribute__((ext_vector_type(2)));

template <class Epi, class Sched, bool ALIGN_EPI = false, bool SP2 = false>
__device__ __forceinline__ void gemm_phase(PG8_LAS unsigned char* lds, const Gemm g, const Sched& S, const Epi& E) {
    int tid_l = threadIdx.x; asm volatile("" : "+v"(tid_l)); const int tid = tid_l, wid = __builtin_amdgcn_readfirstlane(tid >> 6), lane = tid & 63, wr = wid >> 2, wc = wid & 3, fr = lane & 15, fq = lane >> 4;
    const int K = g.K, nt = K / BK;
    unsigned voffA[2], voffB[2];
#pragma unroll
    for (int i = 0; i < 2; ++i) { int R, C; stage_rc(tid * 16 + i * 8192, R, C); const int Rb = Epi::PERM ? ((R & ~31) + perm32(R & 31)) : R;
        voffA[i] = (unsigned)(R * K + C) * 2u; voffB[i] = (unsigned)(Rb * K + C) * 2u; }
    const size_t kstep = (size_t)(BK * 2);
    const size_t hstep = (size_t)HALF * K * 2;
    const size_t tstep = 2 * hstep;
    const unsigned ldsw = (unsigned)wid * 1024u;
    const int aoff = lds_byte(wr * 64 + fr, fq * 8), boff = lds_byte(wc * 32 + fr, fq * 8);
#define PG8_SA(b, h) (((b) * 2 + (h)) * HTB)
#define PG8_SB(b, h) ((4 + (b) * 2 + (h)) * HTB)
#define PG8_STAGE(bufoff, gbase, voff) do { _Pragma("unroll") for (int _i = 0; _i < 2; ++_i) \
        __builtin_amdgcn_global_load_lds((const unsigned*)((const char*)(gbase) + (voff)[_i]), (PG8_LAS unsigned*)(lds + (bufoff) + ldsw + _i * 8192), 16, 0, 0); } while (0)
#define PG8_LDA(dst, b, h) do { _Pragma("unroll") for (int m = 0; m < 4; ++m) _Pragma("unroll") for (int k = 0; k < 2; ++k) dst[m][k] = *(const PG8_LAS bf16x8*)(lds + PG8_SA(b, h) + aoff + m * 2048 + k * 1024); } while (0)
#define PG8_LDB(dst, b, h) do { _Pragma("unroll") for (int n = 0; n < 2; ++n) _Pragma("unroll") for (int k = 0; k < 2; ++k) dst[n][k] = *(const PG8_LAS bf16x8*)(lds + PG8_SB(b, h) + boff + n * 2048 + k * 1024); } while (0)
#define PG8_MMA(ai, bj, At, Bt) do { __builtin_amdgcn_s_setprio(1); _Pragma("unroll") for (int m = 0; m < 4; ++m) _Pragma("unroll") for (int n = 0; n < 2; ++n) _Pragma("unroll") for (int k = 0; k < 2; ++k) \
        acc[ai][bj][m][n] = __builtin_amdgcn_mfma_f32_16x16x32_bf16(Bt[n][k], At[m][k], acc[ai][bj][m][n], 0, 0, 0); __builtin_amdgcn_s_setprio(0); } while (0)
#define PG8_WAIT_V(n) asm volatile("s_waitcnt vmcnt(" #n ")" ::: "memory")
#define PG8_WAIT_L(n) asm volatile("s_waitcnt lgkmcnt(" #n ")" ::: "memory")
#define PG8_BAR __builtin_amdgcn_s_barrier()
#define PG8_SCHED __builtin_amdgcn_sched_barrier(0)
    Unit cur, nxt; int ui = 0;
    if (!S.next(0, cur)) return;
    f32x4 acc[2][2][4][2];
#pragma unroll
    for (int a = 0; a < 2; ++a)
#pragma unroll
        for (int b = 0; b < 2; ++b)
#pragma unroll
            for (int m = 0; m < 4; ++m)
#pragma unroll
                for (int n = 0; n < 2; ++n) acc[a][b][m][n] = (f32x4){0.f, 0.f, 0.f, 0.f};
    bf16x8 At[4][2], B0[2][2], B1[2][2];
    const char* cA = (const char*)g.A + (size_t)cur.pm * tstep; const char* cB = (const char*)g.Bt + (size_t)cur.pn * tstep;
    S.a_ready(cur);
    if constexpr (SP2) {
        PG8_STAGE(PG8_SB(0, 0), cB, voffB); PG8_STAGE(PG8_SB(0, 1), cB + hstep, voffB); PG8_STAGE(PG8_SA(0, 0), cA, voffA); PG8_STAGE(PG8_SA(0, 1), cA + hstep, voffA);
        if (wr == 1) PG8_BAR;
        PG8_WAIT_V(2); PG8_BAR;
        PG8_STAGE(PG8_SB(1, 0), cB + kstep, voffB); PG8_STAGE(PG8_SA(1, 0), cA + kstep, voffA); PG8_STAGE(PG8_SB(1, 1), cB + hstep + kstep, voffB);
        PG8_WAIT_V(6); PG8_BAR;
    } else {
        PG8_STAGE(PG8_SB(0, 0), cB, voffB); PG8_STAGE(PG8_SA(0, 0), cA, voffA); PG8_STAGE(PG8_SB(0, 1), cB + hstep, voffB); PG8_STAGE(PG8_SA(0, 1), cA + hstep, voffA);
        if (wr == 1) PG8_BAR;
        PG8_WAIT_V(4); PG8_BAR;
        PG8_STAGE(PG8_SB(1, 0), cB + kstep, voffB); PG8_STAGE(PG8_SA(1, 0), cA + kstep, voffA); PG8_STAGE(PG8_SB(1, 1), cB + hstep + kstep, voffB);
        PG8_WAIT_V(6); PG8_BAR;
    }
    for (;;) {
        const bool has_next = S.next(ui + 1, nxt);
        const char* nA = has_next ? (const char*)g.A + (size_t)nxt.pm * tstep : cA; const char* nB = has_next ? (const char*)g.Bt + (size_t)nxt.pn * tstep : cB;
        for (int t = 0; t < nt; t += 2) {
            const bool last = (t == nt - 2);
            const char* a1 = cA + (size_t)(t + 1) * kstep;
            const char* a2 = last ? nA : cA + (size_t)(t + 2) * kstep; const char* b2 = last ? nB : cB + (size_t)(t + 2) * kstep;
            const char* a3 = a2 + kstep; const char* b3 = b2 + kstep;
            if (last && has_next) S.a_ready(nxt);
            if constexpr (SP2) {
            PG8_LDB(B0, 0, 0); PG8_LDB(B1, 0, 1); PG8_SCHED; PG8_LDA(At, 0, 0); PG8_STAGE(PG8_SA(1, 1), a1 + hstep, voffA);
            PG8_WAIT_V(8); PG8_WAIT_L(0); PG8_BAR; PG8_MMA(0, 0, At, B0); PG8_MMA(0, 1, At, B1); PG8_BAR; PG8_SCHED;
            PG8_LDA(At, 0, 1); PG8_STAGE(PG8_SB(0, 0), b2, voffB); PG8_STAGE(PG8_SB(0, 1), b2 + hstep, voffB); PG8_STAGE(PG8_SA(0, 0), a2, voffA);
            PG8_WAIT_V(8); PG8_WAIT_L(0); PG8_BAR; PG8_MMA(1, 0, At, B0); PG8_MMA(1, 1, At, B1); PG8_BAR; PG8_SCHED;
            PG8_LDB(B0, 1, 0); PG8_LDB(B1, 1, 1); PG8_SCHED; PG8_LDA(At, 1, 0); PG8_STAGE(PG8_SA(0, 1), a2 + hstep, voffA);
            PG8_WAIT_V(8); PG8_WAIT_L(0); PG8_BAR; PG8_MMA(0, 0, At, B0); PG8_MMA(0, 1, At, B1); PG8_BAR; PG8_SCHED;
            PG8_LDA(At, 1, 1); PG8_STAGE(PG8_SB(1, 0), b3, voffB); PG8_STAGE(PG8_SB(1, 1), b3 + hstep, voffB); PG8_STAGE(PG8_SA(1, 0), a3, voffA);
            PG8_WAIT_V(8); PG8_WAIT_L(0); PG8_BAR; PG8_MMA(1, 0, At, B0); PG8_MMA(1, 1, At, B1); PG8_BAR; PG8_SCHED;
            } else {
            PG8_LDB(B0, 0, 0); PG8_SCHED; PG8_LDA(At, 0, 0); PG8_STAGE(PG8_SA(1, 1), a1 + hstep, voffA);
            PG8_WAIT_L(8); PG8_BAR; PG8_WAIT_L(0); PG8_MMA(0, 0, At, B0); PG8_BAR; PG8_SCHED;
            PG8_LDB(B1, 0, 1); PG8_STAGE(PG8_SB(0, 0), b2, voffB);
            PG8_BAR; PG8_WAIT_L(0); PG8_MMA(0, 1, At, B1); PG8_BAR;
            PG8_LDA(At, 0, 1); PG8_STAGE(PG8_SA(0, 0), a2, voffA);
            PG8_BAR; PG8_WAIT_L(0); PG8_MMA(1, 0, At, B0); PG8_BAR; PG8_SCHED;
            PG8_STAGE(PG8_SB(0, 1), b2 + hstep, voffB);
            PG8_WAIT_V(6); PG8_BAR; PG8_MMA(1, 1, At, B1); PG8_BAR;
            PG8_LDB(B0, 1, 0); PG8_SCHED; PG8_LDA(At, 1, 0); PG8_STAGE(PG8_SA(0, 1), a2 + hstep, voffA);
            PG8_WAIT_L(8); PG8_BAR; PG8_WAIT_L(0); PG8_MMA(0, 0, At, B0); PG8_BAR; PG8_SCHED;
            PG8_LDB(B1, 1, 1); PG8_STAGE(PG8_SB(1, 0), b3, voffB);
            PG8_BAR; PG8_WAIT_L(0); PG8_MMA(0, 1, At, B1); PG8_BAR;
            PG8_LDA(At, 1, 1); PG8_STAGE(PG8_SA(1, 0), a3, voffA);
            PG8_BAR; PG8_WAIT_L(0); PG8_MMA(1, 0, At, B0); PG8_BAR; PG8_SCHED;
            PG8_STAGE(PG8_SB(1, 1), b3 + hstep, voffB);
            PG8_WAIT_V(6); PG8_BAR; PG8_MMA(1, 1, At, B1); PG8_BAR;
            }
        }
        if constexpr (ALIGN_EPI) { if (wr == 0) PG8_BAR; }
        if constexpr (!Epi::AFTER_DRAIN) { E(acc, cur, wr, wc, fr, fq); S.done(cur); }
        if (!has_next) break;
#pragma unroll
        for (int a = 0; a < 2; ++a)
#pragma unroll
            for (int b = 0; b < 2; ++b)
#pragma unroll
                for (int m = 0; m < 4; ++m)
#pragma unroll
                    for (int n = 0; n < 2; ++n) acc[a][b][m][n] = (f32x4){0.f, 0.f, 0.f, 0.f};
        cur = nxt; cA = nA; cB = nB; ++ui;
        if constexpr (ALIGN_EPI) { if (wr == 1) PG8_BAR; }
    }
    PG8_WAIT_V(0);
    if constexpr (!ALIGN_EPI) { if (wr == 0) PG8_BAR; }
    PG8_BAR;
    if constexpr (Epi::AFTER_DRAIN) { E.fused(acc, cur, wr, wc, fr, fq, lds, wid, lane); S.done(cur); }
#undef PG8_SA
#undef PG8_SB
#undef PG8_STAGE
#undef PG8_LDA
#undef PG8_LDB
#undef PG8_MMA
#undef PG8_WAIT_V
#undef PG8_WAIT_L
#undef PG8_BAR
#undef PG8_SCHED
}
}


#define LAS __attribute__((address_space(3)))
typedef unsigned short bf16_t;
typedef short s16x4 __attribute__((ext_vector_type(4)));
typedef short s16x8 __attribute__((ext_vector_type(8)));
typedef float f32x4 __attribute__((ext_vector_type(4)));
typedef float f32x2 __attribute__((ext_vector_type(2)));
typedef unsigned u32x4 __attribute__((ext_vector_type(4)));
typedef unsigned u32x2 __attribute__((ext_vector_type(2)));

constexpr int DM = 1024, DFF = 2816, NGU = 5632, NIN = 7936, DEPTH = 4, SEQ = 8192;
constexpr int TOT = 65536 + 256;
constexpr float EPS = 1e-6f;
constexpr int DBG = 0;
constexpr size_t OUT_YP = 0, OUT_YS = 67108864, OUT_POOLP = 67239936, OUT_CONVP = 67485696, OUT_SSMP = 67682304,
                 OUT_POOLS = 71876608, OUT_CONVS = 72122368, OUT_SSMS = 72318976, OUT_VS = 76513280;
constexpr size_t W_GU1 = 0, W_D1 = W_GU1 + (size_t)NGU * DM, W_IN = W_D1 + (size_t)DM * DFF, W_A = W_IN + (size_t)NIN * DM, W_B = W_A + 1024 * 512,
                 W_C = W_B + 1024 * 1024, W_O = W_C + 1024 * 512, W_GU2 = W_O + 1024 * 1024, W_D2 = W_GU2 + (size_t)NGU * DM, W_S = W_D2 + (size_t)DM * DFF,
                 W_END = W_S + 4 * 128 * 128;
constexpr size_t al256(size_t x) { return (x + 255) & ~(size_t)255; }
constexpr size_t O_BAR = 0, O_SSQS = 16384  , O_H = 65536, O_RS = al256(O_H + (size_t)TOT * DM * 2), O_SSQ = al256(O_RS + TOT * 4), O_SSQY = al256(O_SSQ + TOT * 64), O_W = al256(O_SSQY + TOT * 64),
                 O_X = al256(O_W + W_END * 2);
constexpr size_t X_ACT = 0, X_F = al256((size_t)TOT * DFF * 2), X_FFN_END = X_F + (size_t)TOT * DM * 2;
struct MixLay { size_t xa, z, xbc, u, v, gates, dt, xc, zz, yb, decl, end; };
__host__ __device__ inline MixLay mix_layout(int ng) {
    const size_t RG = (size_t)(65536 / ng) + 256, nch = (size_t)(8 / ng) * 64 + 8;
    MixLay m; size_t o = 0;
    m.xa = o; o = al256(o + RG * 512 * 2);
    m.z = o; o = al256(o + RG * 1024 * 2);
    const size_t sx = RG * 2048 * 2, ss = nch * 16 * 64 * 128 * 2;
    m.xbc = o; o = al256(o + (sx > ss ? sx : ss));
    m.u = o; o = al256(o + RG * 512 * 2);
    m.v = o; o = al256(o + RG * 512 * 2);
    m.gates = o; o = al256(o + RG * 3072 * 2);
    m.dt = o; o = al256(o + RG * 16 * 4);
    m.xc = o; o = al256(o + RG * 2048 * 2);
    m.zz = o; o = al256(o + RG * 512 * 2);
    m.yb = o; o = al256(o + RG * 1024 * 2);
    m.decl = o; o = al256(o + nch * 16 * 4);
    m.end = o; return m;
}

struct Params { const float* in[32]; float* out; unsigned char* ws; int ng; int pad; };
enum { I_XP = 0, I_XS, I_SPOOL, I_SCONV, I_SSSM, I_F1PRE, I_F1POST, I_F1GU, I_F1D, I_MPRE, I_MPOST, I_WIN, I_POOLW, I_POOLS, I_CONVW, I_CONVB, I_DTB, I_ALOG, I_SSMD, I_SSMNG,
       I_GNG, I_GNB, I_GWS, I_GBS, I_WBA, I_WBB, I_WBC, I_WOUT, I_F2PRE, I_F2POST, I_F2GU, I_F2D };

__device__ __forceinline__ float bf_lo(unsigned w) { return __uint_as_float(w << 16); }
__device__ __forceinline__ float bf_hi(unsigned w) { return __uint_as_float(w & 0xffff0000u); }
typedef __bf16 bf16x2_t __attribute__((ext_vector_type(2)));
__device__ __forceinline__ unsigned pk2(float lo, float hi) { const f32x2 v = {lo, hi}; const bf16x2_t b = __builtin_convertvector(v, bf16x2_t); return __builtin_bit_cast(unsigned, b); }
__device__ __forceinline__ float sigmoid_f(float x) { return __builtin_amdgcn_rcpf(1.f + __expf(-x)); }
__device__ __forceinline__ float silu_f(float x) { return x * sigmoid_f(x); }
__device__ __forceinline__ float softplus_f(float x) { return x > 20.f ? x : log1pf(__expf(x)); }
__device__ __forceinline__ float wave_sum(float v) {
#pragma unroll
    for (int o = 1; o < 64; o <<= 1) v += __shfl_xor(v, o);
    return v;
}
__device__ __forceinline__ void unpack8(const u32x4 w, float (&f)[8]) {
    f[0] = bf_lo(w.x); f[1] = bf_hi(w.x); f[2] = bf_lo(w.y); f[3] = bf_hi(w.y); f[4] = bf_lo(w.z); f[5] = bf_hi(w.z); f[6] = bf_lo(w.w); f[7] = bf_hi(w.w);
}
__device__ __forceinline__ u32x4 pack8(const float (&f)[8]) { u32x4 w; w.x = pk2(f[0], f[1]); w.y = pk2(f[2], f[3]); w.z = pk2(f[4], f[5]); w.w = pk2(f[6], f[7]); return w; }
__device__ __forceinline__ s16x8 tr_frag(LAS unsigned char* base, int strideB, int k0, int c0, int lane) {
    const int q = lane >> 4, qq = (lane & 15) >> 2, pp = lane & 3;
    LAS unsigned char* p = base + (k0 + 8 * q + qq) * strideB + (c0 + 4 * pp) * 2;
    const s16x4 a = __builtin_amdgcn_ds_read_tr16_b64_v4i16((LAS s16x4*)p);
    const s16x4 b = __builtin_amdgcn_ds_read_tr16_b64_v4i16((LAS s16x4*)(p + 4 * strideB));
    return (s16x8){a.x, a.y, a.z, a.w, b.x, b.y, b.z, b.w};
}
__device__ __forceinline__ s16x8 tr_frag_perm(LAS unsigned char* base, int strideB, int k0, int c0, int lane) {
    const int q = lane >> 4, qq = (lane & 15) >> 2, pp = lane & 3;
    LAS unsigned char* p = base + (k0 + 4 * q + qq) * strideB + (c0 + 4 * pp) * 2;
    const s16x4 a = __builtin_amdgcn_ds_read_tr16_b64_v4i16((LAS s16x4*)p);
    const s16x4 b = __builtin_amdgcn_ds_read_tr16_b64_v4i16((LAS s16x4*)(p + 16 * strideB));
    return (s16x8){a.x, a.y, a.z, a.w, b.x, b.y, b.z, b.w};
}
#define MFMA16(P, Q, C) __builtin_amdgcn_mfma_f32_16x16x32_bf16((P), (Q), (C), 0, 0, 0)

__device__ __forceinline__ float sum16(const float* p) {
    const f32x4 a = *(const f32x4*)p, b = *(const f32x4*)(p + 4), c = *(const f32x4*)(p + 8), d = *(const f32x4*)(p + 12);
    return (((a.x + a.y) + (a.z + a.w)) + ((b.x + b.y) + (b.z + b.w))) + (((c.x + c.y) + (c.z + c.w)) + ((d.x + d.y) + (d.z + d.w)));
}
struct EpiSwiglu {
    static constexpr bool PERM = true, AFTER_DRAIN = false;
    bf16_t* act; const float* rs;
    __device__ __forceinline__ void operator()(const f32x4 (&acc)[2][2][4][2], const pg8::Unit& u, int wr, int wc, int fr, int fq) const {
        const int row0 = u.pm * 256 + wr * 64 + fr, col0 = u.pn * 128 + wc * 32 + 8 * fq;
        float rsv[2][4];
#pragma unroll
        for (int ai = 0; ai < 2; ++ai)
#pragma unroll
            for (int m = 0; m < 4; ++m) rsv[ai][m] = rs[row0 + ai * 128 + m * 16];
#pragma unroll
        for (int ai = 0; ai < 2; ++ai)
#pragma unroll
            for (int m = 0; m < 4; ++m) {
                const int row = row0 + ai * 128 + m * 16; const float r = rsv[ai][m]; float o[8];
#pragma unroll
                for (int n = 0; n < 2; ++n)
#pragma unroll
                    for (int j = 0; j < 4; ++j) { const float g = r * acc[ai][0][m][n][j], up = r * acc[ai][1][m][n][j]; o[n * 4 + j] = silu_f(g) * up; }
                *(u32x4*)(act + (size_t)row * DFF + col0) = pack8(o);
                asm volatile("" ::: "memory");
            }
    }
};
struct EpiStoreSsq {
    static constexpr bool PERM = true, AFTER_DRAIN = false;
    bf16_t* out; float* ssq;
    __device__ __forceinline__ void operator()(const f32x4 (&acc)[2][2][4][2], const pg8::Unit& u, int wr, int wc, int fr, int fq) const {
        const int row0 = u.pm * 256 + wr * 64 + fr, col0 = u.pn * 256 + wc * 32 + 8 * fq;
#pragma unroll
        for (int ai = 0; ai < 2; ++ai)
#pragma unroll
            for (int m = 0; m < 4; ++m) {
                const int row = row0 + ai * 128 + m * 16; float s = 0.f;
#pragma unroll
                for (int bj = 0; bj < 2; ++bj) { float o[8];
#pragma unroll
                    for (int n = 0; n < 2; ++n)
#pragma unroll
                        for (int j = 0; j < 4; ++j) { const float v = acc[ai][bj][m][n][j]; o[n * 4 + j] = v; s += v * v; }
                    *(u32x4*)(out + (size_t)row * DM + col0 + bj * 128) = pack8(o); }
                s += __shfl_xor(s, 16); s += __shfl_xor(s, 32);
                if (fq == 0) ssq[(size_t)row * 16 + u.pn * 4 + wc] = s;
            }
    }
};
struct EpiProj {
    static constexpr bool PERM = true, AFTER_DRAIN = false;
    bf16_t *xa, *z, *xbc, *uu, *vv, *gates; float* dt; const float* rs; const float* dtb;
    __device__ __forceinline__ void operator()(const f32x4 (&acc)[2][2][4][2], const pg8::Unit& u, int wr, int wc, int fr, int fq) const {
        const int row0 = u.pm * 256 + wr * 64 + fr, cl = wc * 32 + 8 * fq; const int pn = u.pn;
        float rsv[2][4];
#pragma unroll
        for (int ai = 0; ai < 2; ++ai)
#pragma unroll
            for (int m = 0; m < 4; ++m) rsv[ai][m] = rs[row0 + ai * 128 + m * 16];
        if (pn == 30) {
            if (wc == 0 && fq < 2) {
#pragma unroll
                for (int ai = 0; ai < 2; ++ai)
#pragma unroll
                    for (int m = 0; m < 4; ++m) { const int row = row0 + ai * 128 + m * 16; const float r = rsv[ai][m];
#pragma unroll
                        for (int n = 0; n < 2; ++n) { f32x4 o;
#pragma unroll
                            for (int j = 0; j < 4; ++j) { const int c = 8 * fq + 4 * n + j; o[j] = softplus_f(r * acc[ai][0][m][n][j] + dtb[c]); }
                            *(f32x4*)(dt + (size_t)row * 16 + 8 * fq + 4 * n) = o; } }
            }
            return;
        }
        bf16_t* dst; int ld, c0, act;
        if (pn < 2) { dst = xa; ld = 512; c0 = pn * 256; act = 0; }
        else if (pn < 6) { dst = z; ld = 1024; c0 = (pn - 2) * 256; act = 1; }
        else if (pn < 14) { dst = xbc; ld = 2048; c0 = (pn - 6) * 256; act = 0; }
        else if (pn < 16) { dst = uu; ld = 512; c0 = (pn - 14) * 256; act = 0; }
        else if (pn < 18) { dst = vv; ld = 512; c0 = (pn - 16) * 256; act = 0; }
        else { dst = gates; ld = 3072; c0 = (pn - 18) * 256; act = 2; }
#pragma unroll
        for (int ai = 0; ai < 2; ++ai)
#pragma unroll
            for (int m = 0; m < 4; ++m) {
                const int row = row0 + ai * 128 + m * 16; const float r = rsv[ai][m];
#pragma unroll
                for (int bj = 0; bj < 2; ++bj) { float o[8];
#pragma unroll
                    for (int n = 0; n < 2; ++n)
#pragma unroll
                        for (int j = 0; j < 4; ++j) { float v = r * acc[ai][bj][m][n][j]; if (act == 1) v = silu_f(v); else if (act == 2) v = sigmoid_f(v); o[n * 4 + j] = v; }
                    *(u32x4*)(dst + (size_t)row * ld + c0 + bj * 128 + cl) = pack8(o); }
            }
    }
};
template <int MODE> struct EpiMerge {
    static constexpr bool PERM = true, AFTER_DRAIN = false;
    bf16_t* out; const bf16_t* gate; const float* ssqy;
    __device__ __forceinline__ void operator()(const f32x4 (&acc)[2][2][4][2], const pg8::Unit& u, int wr, int wc, int fr, int fq) const {
        const int row0 = u.pm * 256 + wr * 64 + fr, col0 = u.pn * 256 + wc * 32 + 8 * fq;
#pragma unroll
        for (int ai = 0; ai < 2; ++ai)
#pragma unroll
            for (int m = 0; m < 4; ++m) {
                const int row = row0 + ai * 128 + m * 16; float r = 1.f;
                if (MODE == 1) r = rsqrtf(sum16(ssqy + (size_t)row * 16) * (1.f / 1024.f) + EPS);
#pragma unroll
                for (int bj = 0; bj < 2; ++bj) {
                    float g[8], o[8]; unpack8(*(const u32x4*)(gate + (size_t)row * 3072 + col0 + bj * 128), g);
                    bf16_t* op = out + (size_t)row * DM + col0 + bj * 128;
                    if (MODE != 0) unpack8(*(const u32x4*)op, o); else {
#pragma unroll
                        for (int e = 0; e < 8; ++e) o[e] = 0.f; }
#pragma unroll
                    for (int n = 0; n < 2; ++n)
#pragma unroll
                        for (int j = 0; j < 4; ++j) o[n * 4 + j] += g[n * 4 + j] * (r * acc[ai][bj][m][n][j]);
                    *(u32x4*)op = pack8(o); }
                asm volatile("" ::: "memory");
            }
    }
};

#define XB_TMO      128
#define XB_XCNT(j)  (256  + 64 * (j))
#define XB_XSUB(j)  (1280 + 64 * (j))
#define XB_XGEN(j)  (2304 + 64 * (j))
#define XB_TOP      3328
#define XB_TOPGEN   3392
#define XCD_BAR_WORDS 3456
#define XB_SPIN_CAP (1u << 18)

__device__ __forceinline__ unsigned xb_ld(unsigned* p)              { return __hip_atomic_load(p, __ATOMIC_RELAXED, __HIP_MEMORY_SCOPE_AGENT); }
__device__ __forceinline__ unsigned xb_add(unsigned* p, unsigned v) { return __hip_atomic_fetch_add(p, v, __ATOMIC_RELAXED, __HIP_MEMORY_SCOPE_AGENT); }
__device__ __forceinline__ unsigned xb_xcc_id() { return (unsigned)__builtin_amdgcn_s_getreg((3 << 11) | 20) & 0xFu; }
#define XB_SPIN(cond, bar) do { unsigned _sp = 0; while (cond) { __builtin_amdgcn_s_sleep(1); \
    if ((++_sp & 255u) == 0u) { if (xb_ld(&(bar)[XB_TMO])) break; if (_sp > XB_SPIN_CAP) { atomicAdd(&(bar)[XB_TMO], 1u); break; } } } } while (0)

struct XcdBarrier {
    unsigned* bar; unsigned x;
    volatile LAS unsigned* st;
};

__device__ __forceinline__ XcdBarrier xcd_barrier_post(unsigned* bar, volatile LAS unsigned* st) {
    XcdBarrier b; b.bar = bar; b.x = xb_xcc_id(); b.st = st;
    if (threadIdx.x == 0) (void)xb_add(&bar[XB_XCNT(b.x)], 1u);
    return b;
}
__device__ __forceinline__ void xcd_barrier_complete(unsigned* bar, unsigned x, unsigned& nloc, unsigned& nx) {
    const unsigned G = gridDim.x * gridDim.y * gridDim.z;
    unsigned sum, cnt, mine, sp = 0u;
    for (;;) {
        sum = 0u; cnt = 0u; mine = 0u;
#pragma unroll
        for (unsigned j = 0; j < 16; ++j) { const unsigned c = xb_ld(&bar[XB_XCNT(j)]); sum += c; cnt += (c > 0u) ? 1u : 0u; mine = (j == x) ? c : mine; }
        if (sum == G) break;
        __builtin_amdgcn_s_sleep(1);
        if ((++sp & 255u) == 0u) { if (xb_ld(&bar[XB_TMO])) break; if (sp > XB_SPIN_CAP) { atomicAdd(&bar[XB_TMO], 1u); break; } }
    }
    nloc = mine > 0u ? mine : 1u; nx = cnt > 0u ? cnt : 1u;
}

__device__ __forceinline__ void xcd_barrier(const XcdBarrier& b) {
    asm volatile("s_waitcnt vmcnt(0)" ::: "memory");
    __syncthreads();
    if (threadIdx.x == 0) {
        unsigned* bar = b.bar;
        __builtin_amdgcn_s_waitcnt(0);
        unsigned nloc = b.st[0], nx = b.st[1];
        if (nloc == 0u) { xcd_barrier_complete(bar, b.x, nloc, nx); b.st[0] = nloc; b.st[1] = nx; }
        const unsigned old = xb_add(&bar[XB_XSUB(b.x)], 1u);
        const unsigned gen = old / nloc;
        if (old + 1u == (gen + 1u) * nloc) {
            __builtin_amdgcn_fence(__ATOMIC_RELEASE, "agent");
            asm volatile("s_waitcnt vmcnt(0)" ::: "memory");
            const unsigned og = xb_add(&bar[XB_TOP], 1u);
            const unsigned tg = og / nx;
            if (og + 1u == (tg + 1u) * nx) xb_add(&bar[XB_TOPGEN], 1u);
            else XB_SPIN(xb_ld(&bar[XB_TOPGEN]) == tg, bar);
            __builtin_amdgcn_fence(__ATOMIC_ACQUIRE, "agent");
            xb_add(&bar[XB_XGEN(b.x)], 1u);
            asm volatile("s_waitcnt vmcnt(0)" ::: "memory");
        } else {
            XB_SPIN(xb_ld(&bar[XB_XGEN(b.x)]) == gen, bar);
            __builtin_amdgcn_fence(__ATOMIC_ACQUIRE, "agent");
            asm volatile("s_waitcnt vmcnt(0)" ::: "memory");
        }
    }
    __syncthreads();
}

constexpr int LDS_BYTES = 147456, TAB_OFF = LDS_BYTES - 512;
struct Ctx {
    LAS unsigned char* lds; int tid, lane, wave, bid, G, ng;
    float* out; unsigned char* ws0;
    __device__ __forceinline__ const float* in(int i) const {
        const unsigned long long v = ((const LAS unsigned long long*)(lds + TAB_OFF))[i];
        const unsigned lo = __builtin_amdgcn_readfirstlane((unsigned)v), hi = __builtin_amdgcn_readfirstlane((unsigned)(v >> 32));
        return (const float*)(((unsigned long long)hi << 32) | lo);
    }
    __device__ __forceinline__ unsigned char* wsf() const { unsigned char* p = ws0; asm volatile("" : "+s"(p)); return p; }
    __device__ __forceinline__ int tidf() const { int t = tid; asm volatile("" : "+v"(t)); return t; }
    __device__ __forceinline__ int ngf() const { int n = ng; asm volatile("" : "+s"(n)); return n; }
};
struct Grp { int g, nbg, tg, row0, nrows, psoff, nsc; };
__device__ __forceinline__ Grp make_grp(int g, int ng) {
    Grp r; r.g = g; r.nbg = 8 / ng; r.tg = 65536 / ng; r.psoff = (g == 0) ? 256 : 0; r.nsc = (g == 0) ? 8 : 0;
    r.row0 = (g == 0) ? 0 : 256 + g * r.tg; r.nrows = r.tg + r.psoff; return r;
}


struct SkStoreSsq { bf16_t* out; float* ssqs;
    __device__ __forceinline__ void operator()(int row, int col0, int ct, const f32x4 v, int q) const {
        u32x2 o; o.x = pk2(v[0], v[1]); o.y = pk2(v[2], v[3]); *(u32x2*)(out + (size_t)row * DM + col0) = o;
        float s = v[0] * v[0] + v[1] * v[1] + v[2] * v[2] + v[3] * v[3]; s += __shfl_xor(s, 16); s += __shfl_xor(s, 32);
        if (q == 0) ssqs[row * 64 + ct] = s; } };
template <int MODE> struct SkMerge { bf16_t* out; const bf16_t* gate; const float* ssqy;
    __device__ __forceinline__ void operator()(int row, int col0, int ct, const f32x4 v, int q) const {
        float r = 1.f; if (MODE == 1) r = rsqrtf(sum16(ssqy + (size_t)row * 16) * (1.f / 1024.f) + EPS);
        const u32x2 gw = *(const u32x2*)(gate + (size_t)row * 3072 + col0); bf16_t* op = out + (size_t)row * DM + col0;
        float o0 = 0.f, o1 = 0.f, o2 = 0.f, o3 = 0.f;
        if (MODE != 0) { const u32x2 ow = *(const u32x2*)op; o0 = bf_lo(ow.x); o1 = bf_hi(ow.x); o2 = bf_lo(ow.y); o3 = bf_hi(ow.y); }
        o0 += bf_lo(gw.x) * (r * v[0]); o1 += bf_hi(gw.x) * (r * v[1]); o2 += bf_lo(gw.y) * (r * v[2]); o3 += bf_hi(gw.y) * (r * v[3]);
        u32x2 o; o.x = pk2(o0, o1); o.y = pk2(o2, o3); *(u32x2*)op = o; } };
template <class EpiS> __device__ __forceinline__ void skinny_gemm(const Ctx& C, const bf16_t* A, const bf16_t* Bt, int K, const EpiS& E) {
    const int tid_ = C.tidf(), lane_ = tid_ & 63, wave_ = __builtin_amdgcn_readfirstlane(tid_ >> 6), r = lane_ & 15, q = lane_ >> 4;
    const int ks = K >> 3, nst = ks >> 5;
    for (int task = C.bid; task < 256; task += C.G) {
        const int ct = task >> 2, rq = task & 3;
        f32x4 acc[2] = {(f32x4){0.f, 0.f, 0.f, 0.f}, (f32x4){0.f, 0.f, 0.f, 0.f}};
        const bf16_t* bp = Bt + (size_t)(ct * 16 + r) * K + wave_ * ks + q * 8; const bf16_t* ap = A + (size_t)(rq * 32 + r) * K + wave_ * ks + q * 8;
#pragma unroll 1
        for (int s0 = 0; s0 < nst; s0 += 4) {
            s16x8 Bf[4], A0[4], A1[4];
#pragma unroll
            for (int j = 0; j < 4; ++j) if (s0 + j < nst) { Bf[j] = *(const s16x8*)(bp + (s0 + j) * 32); A0[j] = *(const s16x8*)(ap + (s0 + j) * 32); A1[j] = *(const s16x8*)(ap + (size_t)16 * K + (s0 + j) * 32); }
#pragma unroll
            for (int j = 0; j < 4; ++j) if (s0 + j < nst) { acc[0] = MFMA16(Bf[j], A0[j], acc[0]); acc[1] = MFMA16(Bf[j], A1[j], acc[1]); }
        }
        *(LAS f32x4*)(C.lds + ((wave_ * 2 + 0) * 64 + lane_) * 16) = acc[0]; *(LAS f32x4*)(C.lds + ((wave_ * 2 + 1) * 64 + lane_) * 16) = acc[1];
        __syncthreads();
        if (wave_ < 2) {
            f32x4 v = (f32x4){0.f, 0.f, 0.f, 0.f};
#pragma unroll
            for (int w = 0; w < 8; ++w) v += *(const LAS f32x4*)(C.lds + ((w * 2 + wave_) * 64 + lane_) * 16);
            E((rq * 2 + wave_) * 16 + r, ct * 16 + 4 * q, ct, v, q);
        }
        __syncthreads();
    }
}
__device__ __forceinline__ void skinny_swiglu(const Ctx& C, const bf16_t* A, const bf16_t* Bt, const float* rs, bf16_t* act) {
    const int tid_ = C.tidf(), lane_ = tid_ & 63, wave_ = __builtin_amdgcn_readfirstlane(tid_ >> 6), r = lane_ & 15, q = lane_ >> 4;
    constexpr int K = DM, ks = K / 8, nst = ks / 32;
    for (int ct = C.bid; ct < DFF / 16; ct += C.G) {
        f32x4 ag[8], au[8];
#pragma unroll
        for (int rt = 0; rt < 8; ++rt) { ag[rt] = (f32x4){0.f, 0.f, 0.f, 0.f}; au[rt] = (f32x4){0.f, 0.f, 0.f, 0.f}; }
        const int j0 = ct * 16, brow = 256 * (j0 >> 7) + (j0 & 127) + r;
        const bf16_t* bg = Bt + (size_t)brow * K + wave_ * ks + q * 8; const bf16_t* bu = bg + (size_t)128 * K; const bf16_t* ap = A + (size_t)r * K + wave_ * ks + q * 8;
#pragma unroll 1
        for (int st = 0; st < nst; ++st) {
            const s16x8 Bg = *(const s16x8*)(bg + st * 32), Bu = *(const s16x8*)(bu + st * 32); s16x8 Af[8];
#pragma unroll
            for (int rt = 0; rt < 8; ++rt) Af[rt] = *(const s16x8*)(ap + (size_t)rt * 16 * K + st * 32);
#pragma unroll
            for (int rt = 0; rt < 8; ++rt) { ag[rt] = MFMA16(Bg, Af[rt], ag[rt]); au[rt] = MFMA16(Bu, Af[rt], au[rt]); }
        }
#pragma unroll
        for (int rt = 0; rt < 8; ++rt) { *(LAS f32x4*)(C.lds + ((wave_ * 8 + rt) * 64 + lane_) * 16) = ag[rt]; *(LAS f32x4*)(C.lds + 65536 + ((wave_ * 8 + rt) * 64 + lane_) * 16) = au[rt]; }
        __syncthreads();
        f32x4 g = (f32x4){0.f, 0.f, 0.f, 0.f}, u = (f32x4){0.f, 0.f, 0.f, 0.f};
#pragma unroll
        for (int w = 0; w < 8; ++w) { g += *(const LAS f32x4*)(C.lds + ((w * 8 + wave_) * 64 + lane_) * 16); u += *(const LAS f32x4*)(C.lds + 65536 + ((w * 8 + wave_) * 64 + lane_) * 16); }
        const int row = wave_ * 16 + r; const float rr = rs[row];
        u32x2 o; o.x = pk2(silu_f(rr * g[0]) * (rr * u[0]), silu_f(rr * g[1]) * (rr * u[1])); o.y = pk2(silu_f(rr * g[2]) * (rr * u[2]), silu_f(rr * g[3]) * (rr * u[3]));
        *(u32x2*)(act + (size_t)row * DFF + j0 + 4 * q) = o;
        __syncthreads();
    }
}

template <int MAP> __device__ __forceinline__ int wmap(int n) {
    if (MAP == 0) return n;
    if (MAP == 1) { const int blk = n >> 8, r = n & 255; return (r < 128 ? 0 : DFF) + blk * 128 + (r & 127); }
    if (n < 3584) return n; if (n < 7680) return n + 16; if (n < 7696) return 3584 + (n - 7680); return -1;
}
template <int MAP> __device__ __forceinline__ void transpose_item(const float* W, int K, int N, const float* gk, bf16_t* WT, LAS float* scr, int item, int lane, int Nd) {
    const int nblk = Nd / 64, kb = item / nblk, nb = item % nblk, k0 = 64 * kb, n0 = 64 * nb;
    const int nl = (lane & 15) * 4, kl = lane >> 4;
    const int src = wmap<MAP>(n0 + nl);
#pragma unroll 8
    for (int i = 0; i < 16; ++i) { const int kk = 4 * i + kl; f32x4 v = (f32x4){0.f, 0.f, 0.f, 0.f};
        if (src >= 0) { v = *(const f32x4*)(W + (size_t)(k0 + kk) * N + src); if (gk) v *= gk[k0 + kk]; }
        *(LAS f32x4*)(scr + kk * 68 + nl) = v; }
    asm volatile("s_waitcnt lgkmcnt(0)" ::: "memory");
    const int c = lane & 7;
#pragma unroll
    for (int j = 0; j < 8; ++j) { const int n = (lane >> 3) + 8 * j; const LAS float* sp = scr + (8 * c) * 68 + n;
        u32x4 o; o.x = pk2(sp[0 * 68], sp[1 * 68]); o.y = pk2(sp[2 * 68], sp[3 * 68]); o.z = pk2(sp[4 * 68], sp[5 * 68]); o.w = pk2(sp[6 * 68], sp[7 * 68]);
        *(u32x4*)(WT + (size_t)(n0 + n) * K + k0 + 8 * c) = o; }
    asm volatile("s_waitcnt lgkmcnt(0)" ::: "memory");
}
__device__ __forceinline__ void phase_weights(const Ctx& C, int l) {
    const int tid_ = C.tidf(), lane_ = tid_ & 63, wave_ = __builtin_amdgcn_readfirstlane(tid_ >> 6); (void)lane_; (void)wave_;
    bf16_t* WL = (bf16_t*)(C.wsf() + O_W);
    LAS float* scr = (LAS float*)(C.lds + wave_ * 17408);
    const int gw = C.bid * 8 + wave_, NGW = C.G * 8;
    const int I_GU = (DM / 64) * (NGU / 64), I_D = (DFF / 64) * (DM / 64), I_IN = (DM / 64) * (NIN / 64), I_SQ = (DM / 64) * (DM / 64), I_C = (512 / 64) * (DM / 64);
    const int total = 2 * I_GU + 2 * I_D + I_IN + 2 * I_SQ + I_C;
    for (int it = gw; it < total; it += NGW) {
        int r = it;
        if (r < I_GU) { transpose_item<1>(C.in(I_F1GU) + (size_t)l * DM * NGU, DM, NGU, C.in(I_F1PRE) + l * DM, WL + W_GU1, scr, r, lane_, NGU); continue; } r -= I_GU;
        if (r < I_GU) { transpose_item<1>(C.in(I_F2GU) + (size_t)l * DM * NGU, DM, NGU, C.in(I_F2PRE) + l * DM, WL + W_GU2, scr, r, lane_, NGU); continue; } r -= I_GU;
        if (r < I_D) { transpose_item<0>(C.in(I_F1D) + (size_t)l * DFF * DM, DFF, DM, nullptr, WL + W_D1, scr, r, lane_, DM); continue; } r -= I_D;
        if (r < I_D) { transpose_item<0>(C.in(I_F2D) + (size_t)l * DFF * DM, DFF, DM, nullptr, WL + W_D2, scr, r, lane_, DM); continue; } r -= I_D;
        if (r < I_IN) { transpose_item<2>(C.in(I_WIN) + (size_t)l * DM * 7696, DM, 7696, C.in(I_MPRE) + l * DM, WL + W_IN, scr, r, lane_, NIN); continue; } r -= I_IN;
        if (r < I_SQ) { transpose_item<0>(C.in(I_WBB) + (size_t)l * DM * DM, DM, DM, C.in(I_SSMNG) + l * DM, WL + W_B, scr, r, lane_, DM); continue; } r -= I_SQ;
        if (r < I_SQ) { transpose_item<0>(C.in(I_WOUT) + (size_t)l * DM * DM, DM, DM, nullptr, WL + W_O, scr, r, lane_, DM); continue; } r -= I_SQ;
        transpose_item<0>(C.in(I_WBC) + (size_t)l * 512 * DM, 512, DM, nullptr, WL + W_C, scr, r, lane_, DM);
    }
    const int gt = C.bid * 512 + tid_, NT = C.G * 512;
    const float* pw = C.in(I_POOLW) + (size_t)l * 4 * 128 * 128; const float* psc = C.in(I_POOLS) + l * 512; const float* wa = C.in(I_WBA) + (size_t)l * 512 * DM;
    for (int o = gt; o < 1024 * 512; o += NT) { const int cin = o >> 10, n = o & 1023, g = cin >> 7; float s = 0.f;
        const float* pr = pw + (size_t)cin * 128; const float* sr = psc + g * 128; const float* wr = wa + (size_t)(g * 128) * DM + n;
#pragma unroll 8
        for (int d = 0; d < 128; ++d) s += pr[d] * sr[d] * wr[(size_t)d * DM];
        WL[W_A + (size_t)n * 512 + cin] = (bf16_t)(pk2(s, 0.f) & 0xffffu); }
    const float* gws = C.in(I_GWS) + (size_t)l * 4 * 128 * 128;
    for (int o = gt; o < 4 * 128 * 128; o += NT) { const int t = (o >> 7) & 127, s = o & 127; WL[W_S + o] = (bf16_t)(pk2(s <= t ? gws[o] : 0.f, 0.f) & 0xffffu); }
}

__device__ __forceinline__ void phase_init_rows(const Ctx& C) {
    const int tid_ = C.tidf(), lane_ = tid_ & 63, wave_ = __builtin_amdgcn_readfirstlane(tid_ >> 6); (void)lane_; (void)wave_;
    unsigned char* wsb = C.wsf();
    bf16_t* H = (bf16_t*)(wsb + O_H); float* RS = (float*)(wsb + O_RS);
    const float* xs = C.in(I_XS); const float* xp = C.in(I_XP);
    const int gw = C.bid * 8 + wave_, NGW = C.G * 8;
    for (int r0 = gw; r0 < TOT; r0 += 2 * NGW) {
        f32x4 v[2][4]; bool act[2];
#pragma unroll
        for (int k = 0; k < 2; ++k) { const int row = r0 + k * NGW; act[k] = row < TOT;
            const float* src = !act[k] ? nullptr : (row < 128 ? xs + (size_t)row * DM : (row < 256 ? nullptr : xp + (size_t)(row - 256) * DM));
#pragma unroll
            for (int i = 0; i < 2; ++i) { const int c = i * 512 + lane_ * 8;
                v[k][2 * i] = src ? *(const f32x4*)(src + c) : (f32x4){0.f, 0.f, 0.f, 0.f}; v[k][2 * i + 1] = src ? *(const f32x4*)(src + c + 4) : (f32x4){0.f, 0.f, 0.f, 0.f}; } }
#pragma unroll
        for (int k = 0; k < 2; ++k) { const int row = r0 + k * NGW; float ss = 0.f;
#pragma unroll
            for (int i = 0; i < 2; ++i) { const int c = i * 512 + lane_ * 8; const f32x4 a = v[k][2 * i], b = v[k][2 * i + 1];
                const float f[8] = {a.x, a.y, a.z, a.w, b.x, b.y, b.z, b.w};
#pragma unroll
                for (int e = 0; e < 8; ++e) ss += f[e] * f[e];
                if (act[k]) *(u32x4*)(H + (size_t)row * DM + c) = pack8(f); }
            ss = wave_sum(ss);
            if (lane_ == 0 && act[k]) RS[row] = rsqrtf(ss * (1.f / 1024.f) + EPS); }
    }
}
__device__ __forceinline__ void phase_rowpass(const Ctx& C, int rbeg, int rcnt, const bf16_t* F, int frow0, const float* gpost, float coef, bool final) {
    const int tid_ = C.tidf(), lane_ = tid_ & 63, wave_ = __builtin_amdgcn_readfirstlane(tid_ >> 6); (void)lane_; (void)wave_;
    unsigned char* wsb = C.wsf();
    bf16_t* H = (bf16_t*)(wsb + O_H); float* RS = (float*)(wsb + O_RS); float* SSQ = (float*)(wsb + O_SSQ);
    const int gw = C.bid * 8 + wave_, NGW = C.G * 8;
    float g[2][8];
#pragma unroll
    for (int i = 0; i < 2; ++i) { const int c = i * 512 + lane_ * 8; const f32x4 ga = *(const f32x4*)(gpost + c), gb = *(const f32x4*)(gpost + c + 4);
        g[i][0] = ga.x; g[i][1] = ga.y; g[i][2] = ga.z; g[i][3] = ga.w; g[i][4] = gb.x; g[i][5] = gb.y; g[i][6] = gb.z; g[i][7] = gb.w; }
    for (int rr = gw; rr < rcnt; rr += 2 * NGW) {
        u32x4 fw[2][2], hw[2][2]; float ssum[2]; bool act[2];
#pragma unroll
        for (int k = 0; k < 2; ++k) { const int row = rbeg + rr + k * NGW; act[k] = (rr + k * NGW) < rcnt;
            if (act[k]) {
                if (row < 128) { const float* sp = (const float*)(wsb + O_SSQS) + row * 64; ssum[k] = (sum16(sp) + sum16(sp + 16)) + (sum16(sp + 32) + sum16(sp + 48)); }
                else ssum[k] = sum16(SSQ + (size_t)row * 16);
#pragma unroll
                for (int i = 0; i < 2; ++i) { const int c = i * 512 + lane_ * 8; fw[k][i] = *(const u32x4*)(F + (size_t)(row - frow0) * DM + c); hw[k][i] = *(const u32x4*)(H + (size_t)row * DM + c); } }
            else { ssum[k] = 0.f;
#pragma unroll
                for (int i = 0; i < 2; ++i) { fw[k][i] = (u32x4){0u, 0u, 0u, 0u}; hw[k][i] = (u32x4){0u, 0u, 0u, 0u}; } } }
#pragma unroll
        for (int k = 0; k < 2; ++k) { const int row = rbeg + rr + k * NGW;
            const float sc = coef * rsqrtf(ssum[k] * (1.f / 1024.f) + EPS); float ss = 0.f;
            float* orow = nullptr;
            if (final && act[k]) { if (row < 128) orow = C.out + OUT_YS + (size_t)row * DM; else if (row >= 256) orow = C.out + OUT_YP + (size_t)(row - 256) * DM; }
#pragma unroll
            for (int i = 0; i < 2; ++i) { const int c = i * 512 + lane_ * 8; float f[8], h[8]; unpack8(fw[k][i], f); unpack8(hw[k][i], h);
#pragma unroll
                for (int e = 0; e < 8; ++e) { h[e] += sc * f[e] * g[i][e]; ss += h[e] * h[e]; }
                if (act[k]) *(u32x4*)(H + (size_t)row * DM + c) = pack8(h);
                if (orow) { *(f32x4*)(orow + c) = (f32x4){h[0], h[1], h[2], h[3]}; *(f32x4*)(orow + c + 4) = (f32x4){h[4], h[5], h[6], h[7]}; } }
            ss = wave_sum(ss);
            if (lane_ == 0 && act[k]) RS[row] = rsqrtf(ss * (1.f / 1024.f) + EPS); }
    }
}

struct MixBuf { bf16_t *xa, *z, *xbc, *u, *v, *gates, *xc, *zz, *yb, *st; float *dt, *decl; };
__device__ __forceinline__ MixBuf mix_bufs(const Ctx& C) {
    const MixLay L = mix_layout(C.ngf()); unsigned char* X = C.wsf() + O_X; MixBuf b;
    b.xa = (bf16_t*)(X + L.xa); b.z = (bf16_t*)(X + L.z); b.xbc = (bf16_t*)(X + L.xbc); b.u = (bf16_t*)(X + L.u); b.v = (bf16_t*)(X + L.v); b.gates = (bf16_t*)(X + L.gates);
    b.xc = (bf16_t*)(X + L.xc); b.zz = (bf16_t*)(X + L.zz); b.yb = (bf16_t*)(X + L.yb); b.st = (bf16_t*)(X + L.xbc); b.dt = (float*)(X + L.dt); b.decl = (float*)(X + L.decl); return b;
}
__device__ __forceinline__ void tok_block(const Grp& gr, int tb, int& r0, int& b, bool& first, bool& last, int& pos0, bool& samp) {
    if (tb < gr.nsc) { r0 = 16 * tb; b = tb; first = true; last = true; pos0 = 4096; samp = true; }
    else { const int q = tb - gr.nsc, bl = q >> 9, k = q & 511; r0 = gr.psoff + bl * SEQ + 16 * k; b = gr.g * gr.nbg + bl; first = (k == 0); last = (k == 511); pos0 = 16 * k; samp = false; }
}
__device__ __forceinline__ void phase_conv(const Ctx& C, const Grp& gr, int l) {
    const int tid_ = C.tidf(), lane_ = tid_ & 63, wave_ = __builtin_amdgcn_readfirstlane(tid_ >> 6); (void)lane_; (void)wave_;
    const MixBuf B = mix_bufs(C);
    const int ntb = gr.nsc + gr.nbg * 512;
    const int c0 = (tid_ & 255) * 8;
    const float* cw = C.in(I_CONVW) + (size_t)l * 4 * 2048; const float* cb = C.in(I_CONVB) + (size_t)l * 2048;
    float w[4][8], bias[8];
#pragma unroll
    for (int k = 0; k < 4; ++k) { const f32x4 a = *(const f32x4*)(cw + k * 2048 + c0), b2 = *(const f32x4*)(cw + k * 2048 + c0 + 4); w[k][0] = a.x; w[k][1] = a.y; w[k][2] = a.z; w[k][3] = a.w; w[k][4] = b2.x; w[k][5] = b2.y; w[k][6] = b2.z; w[k][7] = b2.w; }
    { const f32x4 a = *(const f32x4*)(cb + c0), b2 = *(const f32x4*)(cb + c0 + 4); bias[0] = a.x; bias[1] = a.y; bias[2] = a.z; bias[3] = a.w; bias[4] = b2.x; bias[5] = b2.y; bias[6] = b2.z; bias[7] = b2.w; }
    for (int it = C.bid; it * 2 < ntb; it += C.G) {
        const int tb = it * 2 + (tid_ >> 8); if (tb >= ntb) continue;
        int r0, b, pos0; bool first, last, samp; tok_block(gr, tb, r0, b, first, last, pos0, samp);
        float x1[8], x2[8], x3[8];
        if (first) {
            if (samp) { const float* hs = C.in(I_SCONV) + ((size_t)(l * 8 + b) * 3) * 2048 + c0;
#pragma unroll
                for (int e = 0; e < 8; ++e) { x3[e] = hs[e]; x2[e] = hs[2048 + e]; x1[e] = hs[4096 + e]; } }
            else {
#pragma unroll
                for (int e = 0; e < 8; ++e) { x1[e] = 0.f; x2[e] = 0.f; x3[e] = 0.f; } }
        } else {
            unpack8(*(const u32x4*)(B.xbc + (size_t)(r0 - 1) * 2048 + c0), x1); unpack8(*(const u32x4*)(B.xbc + (size_t)(r0 - 2) * 2048 + c0), x2); unpack8(*(const u32x4*)(B.xbc + (size_t)(r0 - 3) * 2048 + c0), x3);
        }
        float* cout = C.out + (samp ? OUT_CONVS : OUT_CONVP) + ((size_t)(l * 8 + b) * 3) * 2048 + c0;
        u32x4 xin[16];
#pragma unroll
        for (int t = 0; t < 16; ++t) xin[t] = *(const u32x4*)(B.xbc + (size_t)(r0 + t) * 2048 + c0);
#pragma unroll
        for (int t = 0; t < 16; ++t) {
            float x0[8], o[8]; unpack8(xin[t], x0);
#pragma unroll
            for (int e = 0; e < 8; ++e) { const float a = bias[e] + w[3][e] * x0[e] + w[2][e] * x1[e] + w[1][e] * x2[e] + w[0][e] * x3[e]; o[e] = silu_f(a); }
            *(u32x4*)(B.xc + (size_t)(r0 + t) * 2048 + c0) = pack8(o);
            if (last && t >= 13) { float* p = cout + (t - 13) * 2048; *(f32x4*)p = (f32x4){x0[0], x0[1], x0[2], x0[3]}; *(f32x4*)(p + 4) = (f32x4){x0[4], x0[5], x0[6], x0[7]}; }
#pragma unroll
            for (int e = 0; e < 8; ++e) { x3[e] = x2[e]; x2[e] = x1[e]; x1[e] = x0[e]; }
        }
    }
}
template <int W> __device__ __forceinline__ void pool_block(const Ctx& C, const MixBuf& B, int l, int r0, int b, bool first, bool last, int pos0, bool samp, int c0) {
    float v0[31], v1[31];
#pragma unroll
    for (int i = 0; i < 15; ++i) {
        if (first) { if (samp) { const float* hs = C.in(I_SPOOL) + ((size_t)(l * 8 + b) * 15 + i) * 512 + c0; v0[i] = hs[0]; v1[i] = hs[1]; } else { v0[i] = 0.f; v1[i] = 0.f; } }
        else { const unsigned wv = *(const unsigned*)(B.xa + (size_t)(r0 - 15 + i) * 512 + c0); v0[i] = bf_lo(wv); v1[i] = bf_hi(wv); }
    }
#pragma unroll
    for (int t = 0; t < 16; ++t) { const unsigned wv = *(const unsigned*)(B.xa + (size_t)(r0 + t) * 512 + c0); v0[15 + t] = bf_lo(wv); v1[15 + t] = bf_hi(wv); }
    float* pout = C.out + (samp ? OUT_POOLS : OUT_POOLP) + ((size_t)(l * 8 + b) * 15) * 512 + c0;
#pragma unroll
    for (int t = 0; t < 16; ++t) {
        float s0 = 0.f, s1 = 0.f;
#pragma unroll
        for (int i = 0; i < W; ++i) { s0 += v0[15 + t - i]; s1 += v1[15 + t - i]; }
        const int cn = (pos0 + t + 1) < W ? (pos0 + t + 1) : W; const float inv = 1.f / (float)cn;
        *(unsigned*)(B.zz + (size_t)(r0 + t) * 512 + c0) = pk2(s0 * inv - v0[15 + t], s1 * inv - v1[15 + t]);
        if (last && t >= 1) { pout[(t - 1) * 512] = v0[15 + t]; pout[(t - 1) * 512 + 1] = v1[15 + t]; }
    }
}
__device__ __forceinline__ void phase_pool(const Ctx& C, const Grp& gr, int l) {
    const int tid_ = C.tidf(), lane_ = tid_ & 63, wave_ = __builtin_amdgcn_readfirstlane(tid_ >> 6); (void)lane_; (void)wave_;
    const MixBuf B = mix_bufs(C);
    const int ntb = gr.nsc + gr.nbg * 512; const int c0 = (tid_ & 255) * 2; const int wsel = (wave_ & 3);
    for (int it = C.bid; it * 2 < ntb; it += C.G) {
        const int tb = it * 2 + (tid_ >> 8); if (tb >= ntb) continue;
        int r0, b, pos0; bool first, last, samp; tok_block(gr, tb, r0, b, first, last, pos0, samp);
        if (wsel == 0) pool_block<2>(C, B, l, r0, b, first, last, pos0, samp, c0);
        else if (wsel == 1) pool_block<4>(C, B, l, r0, b, first, last, pos0, samp, c0);
        else if (wsel == 2) pool_block<8>(C, B, l, r0, b, first, last, pos0, samp, c0);
        else pool_block<16>(C, B, l, r0, b, first, last, pos0, samp, c0);
    }
}
constexpr int VN_STRIDE = 1056;
__device__ __forceinline__ void phase_gmlp(const Ctx& C, const Grp& gr, int l) {
    const int tid_ = C.tidf(), lane_ = tid_ & 63, wave_ = __builtin_amdgcn_readfirstlane(tid_ >> 6); (void)lane_; (void)wave_;
    const MixBuf B = mix_bufs(C);
    const int nun = gr.nsc + gr.nbg * 64;
    const bf16_t* WSb = (const bf16_t*)(C.wsf() + O_W) + W_S;
    const float* gng = C.in(I_GNG) + l * 512; const float* gnb = C.in(I_GNB) + l * 512; const float* gbs = C.in(I_GBS) + l * 512;
    const int lane = lane_, r = lane & 15, q = lane >> 4;
    for (int un = C.bid; un < nun; un += C.G) {
        int r0, nvalid, b; bool samp;
        if (un < gr.nsc) { r0 = 16 * un; nvalid = 16; b = un; samp = true; }
        else { const int qq = un - gr.nsc, bl = qq >> 6, k = qq & 63; r0 = gr.psoff + bl * SEQ + 128 * k; nvalid = 128; b = 0; samp = false; }
        {
            const int s = tid_ >> 2, part = tid_ & 3; const bool valid = s < nvalid;
            u32x4 raw[16]; float sum = 0.f, sq = 0.f;
#pragma unroll
            for (int i = 0; i < 16; ++i) { const int col = (i * 4 + part) * 8; raw[i] = valid ? *(const u32x4*)(B.v + (size_t)(r0 + s) * 512 + col) : (u32x4){0u, 0u, 0u, 0u};
                float f[8]; unpack8(raw[i], f);
#pragma unroll
                for (int e = 0; e < 8; ++e) { sum += f[e]; sq += f[e] * f[e]; } }
            sum += __shfl_xor(sum, 1); sum += __shfl_xor(sum, 2); sq += __shfl_xor(sq, 1); sq += __shfl_xor(sq, 2);
            const float mu = sum * (1.f / 512.f); const float var = sq * (1.f / 512.f) - mu * mu; const float rstd = rsqrtf((var > 0.f ? var : 0.f) + EPS);
            float* vout = C.out + OUT_VS + ((size_t)(l * 8 + b) * 16 + s) * 512;
#pragma unroll
            for (int i = 0; i < 16; ++i) { const int col = (i * 4 + part) * 8; float f[8]; unpack8(raw[i], f);
                const f32x4 ga = *(const f32x4*)(gng + col), gb2 = *(const f32x4*)(gng + col + 4), ba = *(const f32x4*)(gnb + col), bb = *(const f32x4*)(gnb + col + 4);
                const float g[8] = {ga.x, ga.y, ga.z, ga.w, gb2.x, gb2.y, gb2.z, gb2.w}, bt[8] = {ba.x, ba.y, ba.z, ba.w, bb.x, bb.y, bb.z, bb.w};
#pragma unroll
                for (int e = 0; e < 8; ++e) f[e] = valid ? (f[e] - mu) * rstd * g[e] + bt[e] : 0.f;
                *(LAS u32x4*)(C.lds + s * VN_STRIDE + col * 2) = pack8(f);
                if (samp && valid) { *(f32x4*)(vout + col) = (f32x4){f[0], f[1], f[2], f[3]}; *(f32x4*)(vout + col + 4) = (f32x4){f[4], f[5], f[6], f[7]}; } }
        }
        __syncthreads();
        {
            const int h = wave_ >> 1, th = wave_ & 1; const int nkb_full = (th + 1) * 2, nkb_v = (nvalid + 31) >> 5; const int nkb = (th * 64 >= nvalid) ? 0 : (nkb_full < nkb_v ? nkb_full : nkb_v);
#pragma unroll 1
            for (int chh = 0; chh < 2; ++chh) {
                f32x4 acc[4][4];
#pragma unroll
                for (int a = 0; a < 4; ++a)
#pragma unroll
                    for (int c = 0; c < 4; ++c) acc[a][c] = (f32x4){0.f, 0.f, 0.f, 0.f};
#pragma unroll 1
                for (int kb = 0; kb < nkb; ++kb) {
                    s16x8 Q[4], P[4];
#pragma unroll
                    for (int tt = 0; tt < 4; ++tt) Q[tt] = *(const s16x8*)(WSb + ((size_t)h * 128 + (th * 4 + tt) * 16 + r) * 128 + kb * 32 + q * 8);
#pragma unroll
                    for (int ct = 0; ct < 4; ++ct) P[ct] = tr_frag(C.lds, VN_STRIDE, kb * 32, h * 128 + chh * 64 + ct * 16, lane);
#pragma unroll
                    for (int ct = 0; ct < 4; ++ct)
#pragma unroll
                        for (int tt = 0; tt < 4; ++tt) acc[ct][tt] = MFMA16(P[ct], Q[tt], acc[ct][tt]);
                }
                u32x2 uq[4][4]; float bsq[4];
#pragma unroll
                for (int tt = 0; tt < 4; ++tt) { const int t = (th * 4 + tt) * 16 + r; const bool tv = t < nvalid; bsq[tt] = tv ? gbs[h * 128 + t] : 0.f;
#pragma unroll
                    for (int ct = 0; ct < 4; ++ct) uq[tt][ct] = tv ? *(const u32x2*)(B.u + (size_t)(r0 + t) * 512 + h * 128 + chh * 64 + ct * 16 + q * 4) : (u32x2){0u, 0u}; }
#pragma unroll
                for (int tt = 0; tt < 4; ++tt) { const int t = (th * 4 + tt) * 16 + r;
                    if (t < nvalid) { const float bsv = bsq[tt];
#pragma unroll
                        for (int ct = 0; ct < 4; ++ct) { const int c = h * 128 + chh * 64 + ct * 16 + q * 4; bf16_t* up = B.u + (size_t)(r0 + t) * 512 + c;
                            const u32x2 uw = uq[tt][ct]; u32x2 o;
                            o.x = pk2(bf_lo(uw.x) * (acc[ct][tt][0] + bsv), bf_hi(uw.x) * (acc[ct][tt][1] + bsv)); o.y = pk2(bf_lo(uw.y) * (acc[ct][tt][2] + bsv), bf_hi(uw.y) * (acc[ct][tt][3] + bsv));
                            *(u32x2*)up = o; } } }
            }
        }
        __syncthreads();
    }
}

constexpr int CH = 128;
__device__ __forceinline__ void ssd_chunk(const Grp& gr, int ci, int& r0, int& nvalid) {
    if (ci < gr.nsc) { r0 = 16 * ci; nvalid = 16; } else { const int qq = ci - gr.nsc, bl = qq >> 6, c = qq & 63; r0 = gr.psoff + bl * SEQ + CH * c; nvalid = CH; }
}
constexpr int XS_STRIDE = 544, BC_STRIDE = 288, BC2_STRIDE = 272;
__device__ __forceinline__ float scan64(float v, int lane) {
#pragma unroll
    for (int o = 1; o < 64; o <<= 1) { const float t = __shfl_up(v, o); if (lane >= o) v += t; }
    return v;
}
__device__ __forceinline__ void chunk_cum128(float v1, float v2, int lane, float& c1, float& c2, float& last) {
    c1 = scan64(v1, lane); const float t1 = __shfl(c1, 63); c2 = scan64(v2, lane) + t1; last = __shfl(c2, 63);
}
__device__ __forceinline__ void phase_ssd_a1(const Ctx& C, const Grp& gr, int l) {
    const int tid_ = C.tidf(), lane_ = tid_ & 63, wave_ = __builtin_amdgcn_readfirstlane(tid_ >> 6);
    const MixBuf B = mix_bufs(C);
    const int nch = gr.nsc + gr.nbg * 64, nun = nch * 4;
    const float* alog = C.in(I_ALOG) + l * 16;
    LAS unsigned char* XW = C.lds; LAS unsigned char* BS = C.lds + CH * XS_STRIDE; LAS float* wS = (LAS float*)(C.lds + CH * XS_STRIDE + CH * BC_STRIDE);
    const int lane = lane_, r = lane & 15, q = lane >> 4;
    const int nit = ((nch + 7) >> 3) * 32;
    for (int it = C.bid; it < nit; it += C.G) {
        const int ci = (it & 7) + 8 * ((it >> 3) >> 2), hg = (it >> 3) & 3; if (ci >= nch) continue;
        (void)nun; int r0, nvalid; ssd_chunk(gr, ci, r0, nvalid);
        const int nkb = (nvalid + 31) >> 5;
        u32x4 gx[8], gb[4];
        { const int ll = tid_ >> 2, quad = tid_ & 3; const bool valid = ll < nvalid;
#pragma unroll
            for (int i = 0; i < 8; ++i) gx[i] = valid ? *(const u32x4*)(B.xc + (size_t)(r0 + ll) * 2048 + hg * 256 + (i * 4 + quad) * 8) : (u32x4){0u, 0u, 0u, 0u};
#pragma unroll
            for (int j = 0; j < 4; ++j) { const int id = tid_ + j * 512, l2 = id >> 4, cb = id & 15;
                gb[j] = l2 < nvalid ? *(const u32x4*)(B.xc + (size_t)(r0 + l2) * 2048 + 1024 + hg * 128 + cb * 8) : (u32x4){0u, 0u, 0u, 0u}; } }
        if (wave_ < 4) { const int h = hg * 4 + wave_;
            const float d1 = lane < nvalid ? B.dt[(size_t)(r0 + lane) * 16 + h] : 0.f, d2 = 64 + lane < nvalid ? B.dt[(size_t)(r0 + 64 + lane) * 16 + h] : 0.f; const float a = -__expf(alog[h]);
            float c1, c2, last; chunk_cum128(d1 * a, d2 * a, lane, c1, c2, last);
            wS[wave_ * CH + lane] = __expf(last - c1) * d1; wS[wave_ * CH + 64 + lane] = __expf(last - c2) * d2;
            if (lane == 0) B.decl[ci * 16 + h] = __expf(last); }
        __syncthreads();
        { const int ll = tid_ >> 2, quad = tid_ & 3; const bool valid = ll < nvalid;
#pragma unroll
            for (int i = 0; i < 8; ++i) { const int ch = (i * 4 + quad) * 8; float f[8];
                if (valid) { unpack8(gx[i], f); const float wv = wS[(i >> 1) * CH + ll];
#pragma unroll
                    for (int e = 0; e < 8; ++e) f[e] *= wv; }
                else {
#pragma unroll
                    for (int e = 0; e < 8; ++e) f[e] = 0.f; }
                *(LAS u32x4*)(XW + ll * XS_STRIDE + ch * 2) = pack8(f); }
#pragma unroll
            for (int j = 0; j < 4; ++j) { const int id = tid_ + j * 512, l2 = id >> 4, cb = id & 15;
                *(LAS u32x4*)(BS + l2 * BC_STRIDE + cb * 16) = gb[j]; } }
        __syncthreads();
        { const int n0 = wave_ * 16; s16x8 P[4];
#pragma unroll
            for (int kb = 0; kb < 4; ++kb) P[kb] = tr_frag(BS, BC_STRIDE, kb * 32, n0, lane);
#pragma unroll
            for (int hh = 0; hh < 4; ++hh)
#pragma unroll
                for (int pt = 0; pt < 4; ++pt) { f32x4 acc = (f32x4){0.f, 0.f, 0.f, 0.f};
#pragma unroll
                    for (int kb = 0; kb < 4; ++kb) if (kb < nkb) { const s16x8 Q = tr_frag(XW, XS_STRIDE, kb * 32, hh * 64 + pt * 16, lane); acc = MFMA16(P[kb], Q, acc); }
                    u32x2 o; o.x = pk2(acc[0], acc[1]); o.y = pk2(acc[2], acc[3]);
                    *(u32x2*)(B.st + (((size_t)ci * 16 + hg * 4 + hh) * 64 + pt * 16 + r) * 128 + n0 + 4 * q) = o; } }
        __syncthreads();
    }
}
__device__ __forceinline__ void phase_ssd_a2(const Ctx& C, const Grp& gr, int l) {
    const int tid_ = C.tidf();
    const MixBuf B = mix_bufs(C);
    const int nseq = gr.nbg + gr.nsc; const int gt = C.bid * 512 + tid_, NT = C.G * 512;
    for (int it = gt; it < nseq * 32768; it += NT) {
        const int sq = it >> 15, e4 = (it & 32767) * 4, h = e4 >> 13;
        if (sq < gr.nbg) {
            const int cbase = gr.nsc + sq * 64; const int b = gr.g * gr.nbg + sq;
            float s[4] = {0.f, 0.f, 0.f, 0.f};
            u32x2 sv[16], sn[16]; float dc[16], dn[16];
#pragma unroll
            for (int j = 0; j < 16; ++j) { sv[j] = *(const u32x2*)(B.st + (size_t)(cbase + j) * 131072 + e4); dc[j] = B.decl[(cbase + j) * 16 + h]; }
#pragma unroll 1
            for (int c0 = 0; c0 < 64; c0 += 16) {
                const bool more = c0 + 16 < 64;
#pragma unroll
                for (int j = 0; j < 16; ++j) { sn[j] = more ? *(const u32x2*)(B.st + (size_t)(cbase + c0 + 16 + j) * 131072 + e4) : (u32x2){0u, 0u}; dn[j] = more ? B.decl[(cbase + c0 + 16 + j) * 16 + h] : 0.f; }
#pragma unroll
                for (int j = 0; j < 16; ++j) { u32x2 o; o.x = pk2(s[0], s[1]); o.y = pk2(s[2], s[3]); *(u32x2*)(B.st + (size_t)(cbase + c0 + j) * 131072 + e4) = o;
                    s[0] = s[0] * dc[j] + bf_lo(sv[j].x); s[1] = s[1] * dc[j] + bf_hi(sv[j].x); s[2] = s[2] * dc[j] + bf_lo(sv[j].y); s[3] = s[3] * dc[j] + bf_hi(sv[j].y); }
#pragma unroll
                for (int j = 0; j < 16; ++j) { sv[j] = sn[j]; dc[j] = dn[j]; }
            }
            *(f32x4*)(C.out + OUT_SSMP + ((size_t)(l * 8 + b)) * 131072 + e4) = (f32x4){s[0], s[1], s[2], s[3]};
        } else {
            const int b = sq - gr.nbg; const f32x4 s0 = *(const f32x4*)(C.in(I_SSSM) + ((size_t)(l * 8 + b)) * 131072 + e4);
            bf16_t* sp = B.st + (size_t)b * 131072 + e4; const u32x2 sv = *(const u32x2*)sp; const float dc = B.decl[b * 16 + h];
            u32x2 o; o.x = pk2(s0.x, s0.y); o.y = pk2(s0.z, s0.w); *(u32x2*)sp = o;
            *(f32x4*)(C.out + OUT_SSMS + ((size_t)(l * 8 + b)) * 131072 + e4) = (f32x4){s0.x * dc + bf_lo(sv.x), s0.y * dc + bf_hi(sv.x), s0.z * dc + bf_lo(sv.y), s0.w * dc + bf_hi(sv.y)};
        }
    }
}
__device__ __forceinline__ void phase_ssd_b(const Ctx& C, const Grp& gr, int l) {
    const int tid_ = C.tidf(), lane_ = tid_ & 63, wave_ = __builtin_amdgcn_readfirstlane(tid_ >> 6);
    const MixBuf B = mix_bufs(C);
    const int nch = gr.nsc + gr.nbg * 64, nun = nch * 4;
    const float* alog = C.in(I_ALOG) + l * 16; const float* dsk = C.in(I_SSMD) + l * 16; float* SSQY = (float*)(C.wsf() + O_SSQY) + (size_t)gr.row0 * 16;
    LAS unsigned char* CS = C.lds; LAS unsigned char* BS = C.lds + CH * BC2_STRIDE; LAS unsigned char* XS = C.lds + 2 * CH * BC2_STRIDE;
    LAS float* cumS = (LAS float*)(C.lds + 2 * CH * BC2_STRIDE + CH * XS_STRIDE); LAS float* dtS = cumS + 4 * CH;
    const int lane = lane_, r = lane & 15, q = lane >> 4;
    const int nit = ((nch + 7) >> 3) * 32;
    for (int it = C.bid; it < nit; it += C.G) {
        const int ci = (it & 7) + 8 * ((it >> 3) >> 2), hg = (it >> 3) & 3; if (ci >= nch) continue;
        (void)nun; int r0, nvalid; ssd_chunk(gr, ci, r0, nvalid);
        const int nlt = (nvalid + 15) >> 4;
        if (wave_ < 4) { const int h = hg * 4 + wave_;
            const float d1 = lane < nvalid ? B.dt[(size_t)(r0 + lane) * 16 + h] : 0.f, d2 = 64 + lane < nvalid ? B.dt[(size_t)(r0 + 64 + lane) * 16 + h] : 0.f; const float a = -__expf(alog[h]);
            float c1, c2, last; chunk_cum128(d1 * a, d2 * a, lane, c1, c2, last);
            cumS[wave_ * CH + lane] = c1; cumS[wave_ * CH + 64 + lane] = c2; dtS[wave_ * CH + lane] = d1; dtS[wave_ * CH + 64 + lane] = d2; }
        { const int ll = tid_ >> 2, quad = tid_ & 3; const bool valid = ll < nvalid;
#pragma unroll
            for (int i = 0; i < 8; ++i) { const int ch = (i * 4 + quad) * 8;
                const u32x4 wv = valid ? *(const u32x4*)(B.xc + (size_t)(r0 + ll) * 2048 + hg * 256 + ch) : (u32x4){0u, 0u, 0u, 0u};
                *(LAS u32x4*)(XS + ll * XS_STRIDE + ch * 2) = wv; }
#pragma unroll
            for (int j = 0; j < 4; ++j) { const int id = tid_ + j * 512, l2 = id >> 4, cb = id & 15; const bool v2 = l2 < nvalid;
                const u32x4 bv = v2 ? *(const u32x4*)(B.xc + (size_t)(r0 + l2) * 2048 + 1024 + hg * 128 + cb * 8) : (u32x4){0u, 0u, 0u, 0u};
                const u32x4 cv = v2 ? *(const u32x4*)(B.xc + (size_t)(r0 + l2) * 2048 + 1536 + hg * 128 + cb * 8) : (u32x4){0u, 0u, 0u, 0u};
                *(LAS u32x4*)(BS + l2 * BC2_STRIDE + cb * 16) = bv; *(LAS u32x4*)(CS + l2 * BC2_STRIDE + cb * 16) = cv; } }
        __syncthreads();
        { const int hh = wave_ >> 1, lh = wave_ & 1, h = hg * 4 + hh; const float dh = dsk[h];
#pragma unroll 1
          for (int ps = 0; ps < 2; ++ps) {
            const int lt0 = lh * 4 + ps * 2;
            if (lt0 >= nlt) continue;
            const int nk2 = (lt0 >> 1) + 1;
            u32x2 zq[2][4];
#pragma unroll
            for (int i = 0; i < 2; ++i) { const int lrow = (lt0 + i) * 16 + r;
#pragma unroll
                for (int pt = 0; pt < 4; ++pt) zq[i][pt] = lrow < nvalid ? *(const u32x2*)(B.z + (size_t)(r0 + lrow) * 1024 + hg * 256 + hh * 64 + pt * 16 + 4 * q) : (u32x2){0u, 0u}; }
            s16x8 Cq[2][4];
#pragma unroll
            for (int i = 0; i < 2; ++i)
#pragma unroll
                for (int kb = 0; kb < 4; ++kb) Cq[i][kb] = *(const LAS s16x8*)(CS + ((lt0 + i) * 16 + r) * BC2_STRIDE + kb * 64 + q * 16);
            s16x8 Mq[2][4];
#pragma unroll
            for (int i = 0; i < 2; ++i) { const int lrow = (lt0 + i) * 16 + r; const float cl = cumS[hh * CH + lrow];
#pragma unroll
                for (int k2 = 0; k2 < 4; ++k2) { unsigned pw[4] = {0u, 0u, 0u, 0u};
                    if (k2 < nk2) {
#pragma unroll
                    for (int s2 = 0; s2 < 2; ++s2) { const int st = k2 * 2 + s2; f32x4 cb = (f32x4){0.f, 0.f, 0.f, 0.f};
#pragma unroll
                        for (int kb = 0; kb < 4; ++kb) { const s16x8 Pb = *(const LAS s16x8*)(BS + (st * 16 + r) * BC2_STRIDE + kb * 64 + q * 16); cb = MFMA16(Pb, Cq[i][kb], cb); }
                        const f32x4 cs4 = *(const LAS f32x4*)(cumS + hh * CH + st * 16 + 4 * q), dt4 = *(const LAS f32x4*)(dtS + hh * CH + st * 16 + 4 * q);
                        float mv[4];
#pragma unroll
                        for (int jj = 0; jj < 4; ++jj) { const int sidx = st * 16 + 4 * q + jj; mv[jj] = sidx <= lrow ? cb[jj] * __expf(cl - cs4[jj]) * dt4[jj] : 0.f; }
                        pw[s2 * 2] = pk2(mv[0], mv[1]); pw[s2 * 2 + 1] = pk2(mv[2], mv[3]); } }
                    const u32x4 t4 = (u32x4){pw[0], pw[1], pw[2], pw[3]}; Mq[i][k2] = __builtin_bit_cast(s16x8, t4); } }
            f32x4 acc[4][2];
#pragma unroll
            for (int pt = 0; pt < 4; ++pt)
#pragma unroll
                for (int i = 0; i < 2; ++i) acc[pt][i] = (f32x4){0.f, 0.f, 0.f, 0.f};
#pragma unroll
            for (int pt = 0; pt < 4; ++pt)
#pragma unroll
                for (int kb = 0; kb < 4; ++kb) { const s16x8 Ps = *(const s16x8*)(B.st + (((size_t)ci * 16 + h) * 64 + pt * 16 + r) * 128 + kb * 32 + q * 8);
#pragma unroll
                    for (int i = 0; i < 2; ++i) acc[pt][i] = MFMA16(Ps, Cq[i][kb], acc[pt][i]); }
#pragma unroll
            for (int i = 0; i < 2; ++i) { const float ec = __expf(cumS[hh * CH + (lt0 + i) * 16 + r]);
#pragma unroll
                for (int pt = 0; pt < 4; ++pt) acc[pt][i] *= ec; }
#pragma unroll
            for (int pt = 0; pt < 4; ++pt)
#pragma unroll
                for (int k2 = 0; k2 < 4; ++k2) if (k2 < nk2) { const s16x8 Px = tr_frag_perm(XS, XS_STRIDE, k2 * 32, hh * 64 + pt * 16, lane);
#pragma unroll
                    for (int i = 0; i < 2; ++i) acc[pt][i] = MFMA16(Px, Mq[i][k2], acc[pt][i]); }
#pragma unroll
            for (int i = 0; i < 2; ++i) { const int lrow = (lt0 + i) * 16 + r; float ss = 0.f; const bool valid = lrow < nvalid;
#pragma unroll
                for (int pt = 0; pt < 4; ++pt) { const int chl = hh * 64 + pt * 16 + 4 * q;
                    const u32x2 xw = *(const LAS u32x2*)(XS + lrow * XS_STRIDE + chl * 2);
                    const u32x2 zw = zq[i][pt];
                    const float y0 = (acc[pt][i][0] + dh * bf_lo(xw.x)) * bf_lo(zw.x), y1 = (acc[pt][i][1] + dh * bf_hi(xw.x)) * bf_hi(zw.x),
                                y2 = (acc[pt][i][2] + dh * bf_lo(xw.y)) * bf_lo(zw.y), y3 = (acc[pt][i][3] + dh * bf_hi(xw.y)) * bf_hi(zw.y);
                    ss += y0 * y0 + y1 * y1 + y2 * y2 + y3 * y3;
                    if (valid) { u32x2 o; o.x = pk2(y0, y1); o.y = pk2(y2, y3); *(u32x2*)(B.yb + (size_t)(r0 + lrow) * 1024 + hg * 256 + chl) = o; } }
                ss += __shfl_xor(ss, 16); ss += __shfl_xor(ss, 32);
                if (q == 0 && valid) SSQY[(size_t)(r0 + lrow) * 16 + h] = ss; }
          }
        }
        __syncthreads();
    }
}

__global__ void __launch_bounds__(512, 2) mega_fwd(Params prm) {
    extern __shared__ __attribute__((aligned(16))) unsigned char lds_raw[];
    cg::grid_group grid = cg::this_grid();
    Ctx C; C.lds = (LAS unsigned char*)lds_raw; C.tid = threadIdx.x; C.lane = C.tid & 63; C.wave = __builtin_amdgcn_readfirstlane(C.tid >> 6); C.bid = blockIdx.x; C.G = gridDim.x;
    C.out = prm.out; C.ws0 = prm.ws; C.ng = prm.ng;
    if (C.tid < 32) ((LAS unsigned long long*)(C.lds + TAB_OFF))[C.tid] = (unsigned long long)prm.in[C.tid];
    if (C.tid < 2) ((volatile LAS unsigned*)(C.lds + TAB_OFF + 256))[C.tid] = 0u;
    __syncthreads();
    const XcdBarrier xbar = xcd_barrier_post((unsigned*)(prm.ws + O_BAR), (volatile LAS unsigned*)(C.lds + TAB_OFF + 256));
#define GSYNC() xcd_barrier(xbar)
#define GSYNC_CG() do { asm volatile("s_waitcnt vmcnt(0) lgkmcnt(0)" ::: "memory"); grid.sync(); } while (0)
#define GEMM_RUN(EPI, Aptr, Bptr, Mrows, Ncols, Kdim, ...) do { pg8::Gemm g_{(const bf16_t*)(Aptr), (const bf16_t*)(Bptr), (Mrows), (Ncols), (Kdim)}; pg8::StaticOrder S_; S_.init((Mrows), (Ncols), C.G, C.bid); \
        EPI E_{__VA_ARGS__}; pg8::gemm_phase<EPI, pg8::StaticOrder, true, true>(C.lds, g_, S_, E_); } while (0)
    phase_init_rows(C);
#pragma unroll 1
    for (int l = 0; l < DEPTH; ++l) {
        phase_weights(C, l);
        if (l == 0) GSYNC_CG(); else GSYNC();
        { unsigned char* w = C.wsf(); GEMM_RUN(EpiSwiglu, (bf16_t*)(w + O_H) + (size_t)256 * DM, (bf16_t*)(w + O_W) + W_GU1, 65536, NGU, DM, (bf16_t*)(w + O_X + X_ACT) + (size_t)256 * DFF, (const float*)(w + O_RS) + 256); }
        { unsigned char* w = C.wsf(); skinny_swiglu(C, (const bf16_t*)(w + O_H), (const bf16_t*)(w + O_W) + W_GU1, (const float*)(w + O_RS), (bf16_t*)(w + O_X + X_ACT)); }
        GSYNC();
        { unsigned char* w = C.wsf(); GEMM_RUN(EpiStoreSsq, (bf16_t*)(w + O_X + X_ACT) + (size_t)256 * DFF, (bf16_t*)(w + O_W) + W_D1, 65536, DM, DFF, (bf16_t*)(w + O_X + X_F) + (size_t)256 * DM, (float*)(w + O_SSQ) + 256 * 16); }
        { unsigned char* w = C.wsf(); const SkStoreSsq E{(bf16_t*)(w + O_X + X_F), (float*)(w + O_SSQS)}; skinny_gemm(C, (const bf16_t*)(w + O_X + X_ACT), (const bf16_t*)(w + O_W) + W_D1, DFF, E); }
        GSYNC();
        { unsigned char* w = C.wsf(); phase_rowpass(C, 0, TOT, (const bf16_t*)(w + O_X + X_F), 0, C.in(I_F1POST) + l * DM, 0.5f, false); }
        GSYNC();
#pragma unroll 1
        for (int gi = 0; gi < (DBG == 1 ? 0 : C.ng); ++gi) {
            const Grp gr = make_grp(gi, C.ng);
            { unsigned char* w = C.wsf(); const MixBuf MB = mix_bufs(C); GEMM_RUN(EpiProj, (bf16_t*)(w + O_H) + (size_t)gr.row0 * DM, (bf16_t*)(w + O_W) + W_IN, gr.nrows, NIN, DM, MB.xa, MB.z, MB.xbc, MB.u, MB.v, MB.gates, MB.dt, (const float*)(w + O_RS) + gr.row0, C.in(I_DTB) + l * 16); }
            GSYNC();
            phase_conv(C, gr, l);
            phase_pool(C, gr, l);
            phase_gmlp(C, gr, l);
            GSYNC();
            if (DBG != 2) { phase_ssd_a1(C, gr, l);
            GSYNC();
            phase_ssd_a2(C, gr, l);
            GSYNC();
            phase_ssd_b(C, gr, l);
            GSYNC(); }
            { unsigned char* w = C.wsf(); const MixBuf MB = mix_bufs(C); const size_t po = gr.psoff; GEMM_RUN(EpiMerge<0>, MB.zz + po * 512, (bf16_t*)(w + O_W) + W_A, gr.tg, DM, 512, MB.z + po * DM, MB.gates + po * 3072, nullptr);
              if (gr.nsc) { const SkMerge<0> E{MB.z, MB.gates, nullptr}; skinny_gemm(C, MB.zz, (const bf16_t*)(w + O_W) + W_A, 512, E); } }
            __syncthreads();
            if (DBG != 2 && DBG != 3) { unsigned char* w = C.wsf(); const MixBuf MB = mix_bufs(C); const size_t po = gr.psoff; GEMM_RUN(EpiMerge<1>, MB.yb + po * DM, (bf16_t*)(w + O_W) + W_B, gr.tg, DM, DM, MB.z + po * DM, MB.gates + po * 3072 + 1024, (const float*)(w + O_SSQY) + ((size_t)gr.row0 + po) * 16);
              if (gr.nsc) { const SkMerge<1> E{MB.z, MB.gates + 1024, (const float*)(w + O_SSQY)}; skinny_gemm(C, MB.yb, (const bf16_t*)(w + O_W) + W_B, DM, E); } }
            __syncthreads();
            { unsigned char* w = C.wsf(); const MixBuf MB = mix_bufs(C); const size_t po = gr.psoff; GEMM_RUN(EpiMerge<2>, MB.u + po * 512, (bf16_t*)(w + O_W) + W_C, gr.tg, DM, 512, MB.z + po * DM, MB.gates + po * 3072 + 2048, nullptr);
              if (gr.nsc) { const SkMerge<2> E{MB.z, MB.gates + 2048, nullptr}; skinny_gemm(C, MB.u, (const bf16_t*)(w + O_W) + W_C, 512, E); } }
            GSYNC();
            { unsigned char* w = C.wsf(); const MixBuf MB = mix_bufs(C); const size_t po = gr.psoff; GEMM_RUN(EpiStoreSsq, MB.z + po * DM, (bf16_t*)(w + O_W) + W_O, gr.tg, DM, DM, MB.yb + po * DM, (float*)(w + O_SSQ) + ((size_t)gr.row0 + po) * 16);
              if (gr.nsc) { const SkStoreSsq E{MB.yb, (float*)(w + O_SSQS)}; skinny_gemm(C, MB.z, (const bf16_t*)(w + O_W) + W_O, DM, E); } }
            GSYNC();
            { const MixBuf MB = mix_bufs(C); phase_rowpass(C, gr.row0, gr.nrows, MB.yb, gr.row0, C.in(I_MPOST) + l * DM, 1.0f, false); }
            GSYNC();
        }
        { unsigned char* w = C.wsf(); GEMM_RUN(EpiSwiglu, (bf16_t*)(w + O_H) + (size_t)256 * DM, (bf16_t*)(w + O_W) + W_GU2, 65536, NGU, DM, (bf16_t*)(w + O_X + X_ACT) + (size_t)256 * DFF, (const float*)(w + O_RS) + 256); }
        { unsigned char* w = C.wsf(); skinny_swiglu(C, (const bf16_t*)(w + O_H), (const bf16_t*)(w + O_W) + W_GU2, (const float*)(w + O_RS), (bf16_t*)(w + O_X + X_ACT)); }
        GSYNC();
        { unsigned char* w = C.wsf(); GEMM_RUN(EpiStoreSsq, (bf16_t*)(w + O_X + X_ACT) + (size_t)256 * DFF, (bf16_t*)(w + O_W) + W_D2, 65536, DM, DFF, (bf16_t*)(w + O_X + X_F) + (size_t)256 * DM, (float*)(w + O_SSQ) + 256 * 16); }
        { unsigned char* w = C.wsf(); const SkStoreSsq E{(bf16_t*)(w + O_X + X_F), (float*)(w + O_SSQS)}; skinny_gemm(C, (const bf16_t*)(w + O_X + X_ACT), (const bf16_t*)(w + O_W) + W_D2, DFF, E); }
        GSYNC();
        { unsigned char* w = C.wsf(); phase_rowpass(C, 0, TOT, (const bf16_t*)(w + O_X + X_F), 0, C.in(I_F2POST) + l * DM, 0.5f, l == DEPTH - 1); }
        GSYNC();
    }
}

extern "C" void kernel_launch(void* const* d_in, const int* in_sizes, int n_in, void* d_out, int out_size, void* d_ws, size_t ws_size, hipStream_t stream) {
    static int grid = 0, ng = 0;
    if (grid == 0) {
        int dev = 0, cus = 0, per_cu = 0;
        hipGetDevice(&dev); hipDeviceGetAttribute(&cus, hipDeviceAttributeMultiprocessorCount, dev);
        if (hipFuncSetAttribute((const void*)mega_fwd, hipFuncAttributeMaxDynamicSharedMemorySize, LDS_BYTES) != hipSuccess) { fprintf(stderr, "hipFuncSetAttribute failed\n"); grid = -1; return; }
        hipOccupancyMaxActiveBlocksPerMultiprocessor(&per_cu, (const void*)mega_fwd, 512, LDS_BYTES);
        (void)hipGetLastError();
        if (per_cu < 1) { fprintf(stderr, "occupancy query says %d blocks per CU\n", per_cu); per_cu = 1; }
        grid = cus;
        ng = 0;
        for (int c = 2; c <= 8; c *= 2) { const MixLay m = mix_layout(c); const size_t xe = m.end > X_FFN_END ? m.end : X_FFN_END; if (O_X + xe <= ws_size) { ng = c; break; } }
        if (ng == 0 || n_in != 32) { fprintf(stderr, "workspace too small (%zu) or unexpected inputs (%d)\n", ws_size, n_in); grid = -1; return; }
    }
    if (grid < 0) return;
    Params p{};
    for (int i = 0; i < 32; ++i) p.in[i] = (const float*)d_in[i];
    p.out = (float*)d_out; p.ws = (unsigned char*)d_ws; p.ng = ng; p.pad = 0;
    if (hipMemsetAsync(d_ws, 0, 65536, stream) != hipSuccess) { fprintf(stderr, "memset of barrier words failed\n"); return; }
    void* args[] = {&p};
    hipError_t e = hipLaunchCooperativeKernel((const void*)mega_fwd, dim3(grid), dim3(512), args, LDS_BYTES, stream);
    if (e != hipSuccess) fprintf(stderr, "cooperative launch failed: %s (grid %d)\n", hipGetErrorString(e), grid);
}
```

```cpp
#include <hip/hip_runtime.h>
#include <hip/hip_cooperative_groups.h>
#include <cstdio>
namespace cg = cooperative_groups;

namespace pg8 {
#define PG8_LAS __attribute__((address_space(3)))
typedef unsigned short bf16_t;
typedef short bf16x8 __attribute__((ext_vector_type(8)));
typedef float f32x4 __attribute__((ext_vector_type(4)));
typedef unsigned u32x4 __attribute__((ext_vector_type(4)));
constexpr int BM = 256, BK = 64, HALF = 128, HTB = HALF * BK * 2  , STAGE_BYTES = 8 * HTB, NXCD = 8, WGM = 4;

__host__ __device__ __forceinline__ int lds_byte(int r, int c) { const int st = (r >> 4) * 2 + (c >> 5), rr = r & 15, cc = c & 31, ob = rr * 64 + cc * 2; return st * 1024 + (ob ^ (((ob >> 9) & 1) << 5)); }
__host__ __device__ __forceinline__ void stage_rc(int b, int& R, int& C) { const int st = b / 1024, sb = b % 1024, swz = sb ^ (((sb >> 9) & 1) << 5); R = (st >> 1) * 16 + swz / 64; C = (st & 1) * 32 + (swz % 64) / 2; }
__host__ __device__ __forceinline__ int perm32(int rho) { const int n = rho >> 4, i = rho & 15; return 8 * (i >> 2) + 4 * n + (i & 3); }

struct Unit { int pm, pn; };
struct Gemm { const bf16_t* A; const bf16_t* Bt; int M, N, K; };

struct StaticOrder {
    int nM, nN, nwg, G, c;
    __host__ __device__ void init(int M, int N, int G_, int c_) { nM = M / BM; nN = N / BM; nwg = nM * nN; G = G_; c = c_; }
    __host__ __device__ bool next(int i, Unit& u) const {
        const long L = (long)i * G + c; if (L >= nwg) return false;
        int wgid = (int)L; { const int q = nwg / NXCD, r = nwg % NXCD, xcd = wgid % NXCD, off = wgid / NXCD; wgid = (xcd < r ? xcd * (q + 1) : r * (q + 1) + (xcd - r) * q) + off; }
        const int nig = WGM * nN, gid = wgid / nig, fm = gid * WGM, gsz = (nM - fm) < WGM ? (nM - fm) : WGM;
        u.pm = fm + ((wgid % nig) % gsz); u.pn = (wgid % nig) / gsz; return true;
    }
    __device__ __forceinline__ void a_ready(const Unit&) const {}
    __device__ __forceinline__ void done(const Unit&) const {}
};

__device__ __forceinline__ unsigned cvt_pk_bf16(float lo, float hi) { unsigned r; asm volatile("v_cvt_pk_bf16_f32 %0, %1, %2" : "=v"(r) : "v"(lo), "v"(hi)); return r; }
typedef float f32x2 __attribute__((ext_vector_type(2)));

template <class Epi, class Sched, bool ALIGN_EPI = false, bool SP2 = false>
__device__ __forceinline__ void gemm_phase(PG8_LAS unsigned char* lds, const Gemm g, const Sched& S, const Epi& E) {
    int tid_l = threadIdx.x; asm volatile("" : "+v"(tid_l)); const int tid = tid_l, wid = __builtin_amdgcn_readfirstlane(tid >> 6), lane = tid & 63, wr = wid >> 2, wc = wid & 3, fr = lane & 15, fq = lane >> 4;
    const int K = g.K, nt = K / BK;
    unsigned voffA[2], voffB[2];
#pragma unroll
    for (int i = 0; i < 2; ++i) { int R, C; stage_rc(tid * 16 + i * 8192, R, C); const int Rb = Epi::PERM ? ((R & ~31) + perm32(R & 31)) : R;
        voffA[i] = (unsigned)(R * K + C) * 2u; voffB[i] = (unsigned)(Rb * K + C) * 2u; }
    const size_t kstep = (size_t)(BK * 2);
    const size_t hstep = (size_t)HALF * K * 2;
    const size_t tstep = 2 * hstep;
    const unsigned ldsw = (unsigned)wid * 1024u;
    const int aoff = lds_byte(wr * 64 + fr, fq * 8), boff = lds_byte(wc * 32 + fr, fq * 8);
#define PG8_SA(b, h) (((b) * 2 + (h)) * HTB)
#define PG8_SB(b, h) ((4 + (b) * 2 + (h)) * HTB)
#define PG8_STAGE(bufoff, gbase, voff) do { _Pragma("unroll") for (int _i = 0; _i < 2; ++_i) \
        __builtin_amdgcn_global_load_lds((const unsigned*)((const char*)(gbase) + (voff)[_i]), (PG8_LAS unsigned*)(lds + (bufoff) + ldsw + _i * 8192), 16, 0, 0); } while (0)
#define PG8_LDA(dst, b, h) do { _Pragma("unroll") for (int m = 0; m < 4; ++m) _Pragma("unroll") for (int k = 0; k < 2; ++k) dst[m][k] = *(const PG8_LAS bf16x8*)(lds + PG8_SA(b, h) + aoff + m * 2048 + k * 1024); } while (0)
#define PG8_LDB(dst, b, h) do { _Pragma("unroll") for (int n = 0; n < 2; ++n) _Pragma("unroll") for (int k = 0; k < 2; ++k) dst[n][k] = *(const PG8_LAS bf16x8*)(lds + PG8_SB(b, h) + boff + n * 2048 + k * 1024); } while (0)
#define PG8_MMA(ai, bj, At, Bt) do { __builtin_amdgcn_s_setprio(1); _Pragma("unroll") for (int m = 0; m < 4; ++m) _Pragma("unroll") for (int n = 0; n < 2; ++n) _Pragma("unroll") for (int k = 0; k < 2; ++k) \
        acc[ai][bj][m][n] = __builtin_amdgcn_mfma_f32_16x16x32_bf16(Bt[n][k], At[m][k], acc[ai][bj][m][n], 0, 0, 0); __builtin_amdgcn_s_setprio(0); } while (0)
#define PG8_WAIT_V(n) asm volatile("s_waitcnt vmcnt(" #n ")" ::: "memory")
#define PG8_WAIT_L(n) asm volatile("s_waitcnt lgkmcnt(" #n ")" ::: "memory")
#define PG8_BAR __builtin_amdgcn_s_barrier()
#define PG8_SCHED __builtin_amdgcn_sched_barrier(0)
    Unit cur, nxt; int ui = 0;
    if (!S.next(0, cur)) return;
    f32x4 acc[2][2][4][2];
#pragma unroll
    for (int a = 0; a < 2; ++a)
#pragma unroll
        for (int b = 0; b < 2; ++b)
#pragma unroll
            for (int m = 0; m < 4; ++m)
#pragma unroll
                for (int n = 0; n < 2; ++n) acc[a][b][m][n] = (f32x4){0.f, 0.f, 0.f, 0.f};
    bf16x8 At[4][2], B0[2][2], B1[2][2];
    const char* cA = (const char*)g.A + (size_t)cur.pm * tstep; const char* cB = (const char*)g.Bt + (size_t)cur.pn * tstep;
    S.a_ready(cur);
    if constexpr (SP2) {
        PG8_STAGE(PG8_SB(0, 0), cB, voffB); PG8_STAGE(PG8_SB(0, 1), cB + hstep, voffB); PG8_STAGE(PG8_SA(0, 0), cA, voffA); PG8_STAGE(PG8_SA(0, 1), cA + hstep, voffA);
        if (wr == 1) PG8_BAR;
        PG8_WAIT_V(2); PG8_BAR;
        PG8_STAGE(PG8_SB(1, 0), cB + kstep, voffB); PG8_STAGE(PG8_SA(1, 0), cA + kstep, voffA); PG8_STAGE(PG8_SB(1, 1), cB + hstep + kstep, voffB);
        PG8_WAIT_V(6); PG8_BAR;
    } else {
        PG8_STAGE(PG8_SB(0, 0), cB, voffB); PG8_STAGE(PG8_SA(0, 0), cA, voffA); PG8_STAGE(PG8_SB(0, 1), cB + hstep, voffB); PG8_STAGE(PG8_SA(0, 1), cA + hstep, voffA);
        if (wr == 1) PG8_BAR;
        PG8_WAIT_V(4); PG8_BAR;
        PG8_STAGE(PG8_SB(1, 0), cB + kstep, voffB); PG8_STAGE(PG8_SA(1, 0), cA + kstep, voffA); PG8_STAGE(PG8_SB(1, 1), cB + hstep + kstep, voffB);
        PG8_WAIT_V(6); PG8_BAR;
    }
    for (;;) {
        const bool has_next = S.next(ui + 1, nxt);
        const char* nA = has_next ? (const char*)g.A + (size_t)nxt.pm * tstep : cA; const char* nB = has_next ? (const char*)g.Bt + (size_t)nxt.pn * tstep : cB;
        for (int t = 0; t < nt; t += 2) {
            const bool last = (t == nt - 2);
            const char* a1 = cA + (size_t)(t + 1) * kstep;
            const char* a2 = last ? nA : cA + (size_t)(t + 2) * kstep; const char* b2 = last ? nB : cB + (size_t)(t + 2) * kstep;
            const char* a3 = a2 + kstep; const char* b3 = b2 + kstep;
            if (last && has_next) S.a_ready(nxt);
            if constexpr (SP2) {
            PG8_LDB(B0, 0, 0); PG8_LDB(B1, 0, 1); PG8_SCHED; PG8_LDA(At, 0, 0); PG8_STAGE(PG8_SA(1, 1), a1 + hstep, voffA);
            PG8_WAIT_V(8); PG8_WAIT_L(0); PG8_BAR; PG8_MMA(0, 0, At, B0); PG8_MMA(0, 1, At, B1); PG8_BAR; PG8_SCHED;
            PG8_LDA(At, 0, 1); PG8_STAGE(PG8_SB(0, 0), b2, voffB); PG8_STAGE(PG8_SB(0, 1), b2 + hstep, voffB); PG8_STAGE(PG8_SA(0, 0), a2, voffA);
            PG8_WAIT_V(8); PG8_WAIT_L(0); PG8_BAR; PG8_MMA(1, 0, At, B0); PG8_MMA(1, 1, At, B1); PG8_BAR; PG8_SCHED;
            PG8_LDB(B0, 1, 0); PG8_LDB(B1, 1, 1); PG8_SCHED; PG8_LDA(At, 1, 0); PG8_STAGE(PG8_SA(0, 1), a2 + hstep, voffA);
            PG8_WAIT_V(8); PG8_WAIT_L(0); PG8_BAR; PG8_MMA(0, 0, At, B0); PG8_MMA(0, 1, At, B1); PG8_BAR; PG8_SCHED;
            PG8_LDA(At, 1, 1); PG8_STAGE(PG8_SB(1, 0), b3, voffB); PG8_STAGE(PG8_SB(1, 1), b3 + hstep, voffB); PG8_STAGE(PG8_SA(1, 0), a3, voffA);
            PG8_WAIT_V(8); PG8_WAIT_L(0); PG8_BAR; PG8_MMA(1, 0, At, B0); PG8_MMA(1, 1, At, B1); PG8_BAR; PG8_SCHED;
            } else {
            PG8_LDB(B0, 0, 0); PG8_SCHED; PG8_LDA(At, 0, 0); PG8_STAGE(PG8_SA(1, 1), a1 + hstep, voffA);
            PG8_WAIT_L(8); PG8_BAR; PG8_WAIT_L(0); PG8_MMA(0, 0, At, B0); PG8_BAR; PG8_SCHED;
            PG8_LDB(B1, 0, 1); PG8_STAGE(PG8_SB(0, 0), b2, voffB);
            PG8_BAR; PG8_WAIT_L(0); PG8_MMA(0, 1, At, B1); PG8_BAR;
            PG8_LDA(At, 0, 1); PG8_STAGE(PG8_SA(0, 0), a2, voffA);
            PG8_BAR; PG8_WAIT_L(0); PG8_MMA(1, 0, At, B0); PG8_BAR; PG8_SCHED;
            PG8_STAGE(PG8_SB(0, 1), b2 + hstep, voffB);
            PG8_WAIT_V(6); PG8_BAR; PG8_MMA(1, 1, At, B1); PG8_BAR;
            PG8_LDB(B0, 1, 0); PG8_SCHED; PG8_LDA(At, 1, 0); PG8_STAGE(PG8_SA(0, 1), a2 + hstep, voffA);
            PG8_WAIT_L(8); PG8_BAR; PG8_WAIT_L(0); PG8_MMA(0, 0, At, B0); PG8_BAR; PG8_SCHED;
            PG8_LDB(B1, 1, 1); PG8_STAGE(PG8_SB(1, 0), b3, voffB);
            PG8_BAR; PG8_WAIT_L(0); PG8_MMA(0, 1, At, B1); PG8_BAR;
            PG8_LDA(At, 1, 1); PG8_STAGE(PG8_SA(1, 0), a3, voffA);
            PG8_BAR; PG8_WAIT_L(0); PG8_MMA(1, 0, At, B0); PG8_BAR; PG8_SCHED;
            PG8_STAGE(PG8_SB(1, 1), b3 + hstep, voffB);
            PG8_WAIT_V(6); PG8_BAR; PG8_MMA(1, 1, At, B1); PG8_BAR;
            }
        }
        if constexpr (ALIGN_EPI) { if (wr == 0) PG8_BAR; }
        if constexpr (!Epi::AFTER_DRAIN) { E(acc, cur, wr, wc, fr, fq); S.done(cur); }
        if (!has_next) break;
#pragma unroll
        for (int a = 0; a < 2; ++a)
#pragma unroll
            for (int b = 0; b < 2; ++b)
#pragma unroll
                for (int m = 0; m < 4; ++m)
#pragma unroll
                    for (int n = 0; n < 2; ++n) acc[a][b][m][n] = (f32x4){0.f, 0.f, 0.f, 0.f};
        cur = nxt; cA = nA; cB = nB; ++ui;
        if constexpr (ALIGN_EPI) { if (wr == 1) PG8_BAR; }
    }
    PG8_WAIT_V(0);
    if constexpr (!ALIGN_EPI) { if (wr == 0) PG8_BAR; }
    PG8_BAR;
    if constexpr (Epi::AFTER_DRAIN) { E.fused(acc, cur, wr, wc, fr, fq, lds, wid, lane); S.done(cur); }
#undef PG8_SA
#undef PG8_SB
#undef PG8_STAGE
#undef PG8_LDA
#undef PG8_LDB
#undef PG8_MMA
#undef PG8_WAIT_V
#undef PG8_WAIT_L
#undef PG8_BAR
#undef PG8_SCHED
}
}


#define LAS __attribute__((address_space(3)))
typedef unsigned short bf16_t;
typedef short s16x4 __attribute__((ext_vector_type(4)));
typedef short s16x8 __attribute__((ext_vector_type(8)));
typedef float f32x4 __attribute__((ext_vector_type(4)));
typedef float f32x2 __attribute__((ext_vector_type(2)));
typedef unsigned u32x4 __attribute__((ext_vector_type(4)));
typedef unsigned u32x2 __attribute__((ext_vector_type(2)));

constexpr int DM = 1024, DFF = 2816, NGU = 5632, NIN = 7936, DEPTH = 4, SEQ = 8192;
constexpr int TOT = 65536 + 256;
constexpr float EPS = 1e-6f;
constexpr int DBG = 0;
constexpr size_t OUT_YP = 0, OUT_YS = 67108864, OUT_POOLP = 67239936, OUT_CONVP = 67485696, OUT_SSMP = 67682304,
                 OUT_POOLS = 71876608, OUT_CONVS = 72122368, OUT_SSMS = 72318976, OUT_VS = 76513280;
constexpr size_t W_GU1 = 0, W_D1 = W_GU1 + (size_t)NGU * DM, W_IN = W_D1 + (size_t)DM * DFF, W_A = W_IN + (size_t)NIN * DM, W_B = W_A + 1024 * 512,
                 W_C = W_B + 1024 * 1024, W_O = W_C + 1024 * 512, W_GU2 = W_O + 1024 * 1024, W_D2 = W_GU2 + (size_t)NGU * DM, W_S = W_D2 + (size_t)DM * DFF,
                 W_END = W_S + 4 * 128 * 128;
constexpr size_t al256(size_t x) { return (x + 255) & ~(size_t)255; }
constexpr size_t O_BAR = 0, O_SSQS = 16384  , O_H = 65536, O_RS = al256(O_H + (size_t)TOT * DM * 2), O_SSQ = al256(O_RS + TOT * 4), O_SSQY = al256(O_SSQ + TOT * 64), O_W = al256(O_SSQY + TOT * 64),
                 O_X = al256(O_W + W_END * 2);
constexpr size_t X_ACT = 0, X_F = al256((size_t)TOT * DFF * 2), X_FFN_END = X_F + (size_t)TOT * DM * 2;
struct MixLay { size_t xa, z, xbc, u, v, gates, dt, xc, zz, yb, decl, end; };
__host__ __device__ inline MixLay mix_layout(int ng) {
    const size_t RG = (size_t)(65536 / ng) + 256, nch = (size_t)(8 / ng) * 64 + 8;
    MixLay m; size_t o = 0;
    m.xa = o; o = al256(o + RG * 512 * 2);
    m.z = o; o = al256(o + RG * 1024 * 2);
    const size_t sx = RG * 2048 * 2, ss = nch * 16 * 64 * 128 * 2;
    m.xbc = o; o = al256(o + (sx > ss ? sx : ss));
    m.u = o; o = al256(o + RG * 512 * 2);
    m.v = o; o = al256(o + RG * 512 * 2);
    m.gates = o; o = al256(o + RG * 3072 * 2);
    m.dt = o; o = al256(o + RG * 16 * 4);
    m.xc = o; o = al256(o + RG * 2048 * 2);
    m.zz = o; o = al256(o + RG * 512 * 2);
    m.yb = o; o = al256(o + RG * 1024 * 2);
    m.decl = o; o = al256(o + nch * 16 * 4);
    m.end = o; return m;
}

struct Params { const float* in[32]; float* out; unsigned char* ws; int ng; int pad; };
enum { I_XP = 0, I_XS, I_SPOOL, I_SCONV, I_SSSM, I_F1PRE, I_F1POST, I_F1GU, I_F1D, I_MPRE, I_MPOST, I_WIN, I_POOLW, I_POOLS, I_CONVW, I_CONVB, I_DTB, I_ALOG, I_SSMD, I_SSMNG,
       I_GNG, I_GNB, I_GWS, I_GBS, I_WBA, I_WBB, I_WBC, I_WOUT, I_F2PRE, I_F2POST, I_F2GU, I_F2D };

__device__ __forceinline__ float bf_lo(unsigned w) { return __uint_as_float(w << 16); }
__device__ __forceinline__ float bf_hi(unsigned w) { return __uint_as_float(w & 0xffff0000u); }
typedef __bf16 bf16x2_t __attribute__((ext_vector_type(2)));
__device__ __forceinline__ unsigned pk2(float lo, float hi) { const f32x2 v = {lo, hi}; const bf16x2_t b = __builtin_convertvector(v, bf16x2_t); return __builtin_bit_cast(unsigned, b); }
__device__ __forceinline__ float sigmoid_f(float x) { return __builtin_amdgcn_rcpf(1.f + __expf(-x)); }
__device__ __forceinline__ float silu_f(float x) { return x * sigmoid_f(x); }
__device__ __forceinline__ float softplus_f(float x) { return x > 20.f ? x : log1pf(__expf(x)); }
__device__ __forceinline__ float wave_sum(float v) {
#pragma unroll
    for (int o = 1; o < 64; o <<= 1) v += __shfl_xor(v, o);
    return v;
}
__device__ __forceinline__ void unpack8(const u32x4 w, float (&f)[8]) {
    f[0] = bf_lo(w.x); f[1] = bf_hi(w.x); f[2] = bf_lo(w.y); f[3] = bf_hi(w.y); f[4] = bf_lo(w.z); f[5] = bf_hi(w.z); f[6] = bf_lo(w.w); f[7] = bf_hi(w.w);
}
__device__ __forceinline__ u32x4 pack8(const float (&f)[8]) { u32x4 w; w.x = pk2(f[0], f[1]); w.y = pk2(f[2], f[3]); w.z = pk2(f[4], f[5]); w.w = pk2(f[6], f[7]); return w; }
__device__ __forceinline__ s16x8 tr_frag(LAS unsigned char* base, int strideB, int k0, int c0, int lane) {
    const int q = lane >> 4, qq = (lane & 15) >> 2, pp = lane & 3;
    LAS unsigned char* p = base + (k0 + 8 * q + qq) * strideB + (c0 + 4 * pp) * 2;
    const s16x4 a = __builtin_amdgcn_ds_read_tr16_b64_v4i16((LAS s16x4*)p);
    const s16x4 b = __builtin_amdgcn_ds_read_tr16_b64_v4i16((LAS s16x4*)(p + 4 * strideB));
    return (s16x8){a.x, a.y, a.z, a.w, b.x, b.y, b.z, b.w};
}
__device__ __forceinline__ s16x8 tr_frag_perm(LAS unsigned char* base, int strideB, int k0, int c0, int lane) {
    const int q = lane >> 4, qq = (lane & 15) >> 2, pp = lane & 3;
    LAS unsigned char* p = base + (k0 + 4 * q + qq) * strideB + (c0 + 4 * pp) * 2;
    const s16x4 a = __builtin_amdgcn_ds_read_tr16_b64_v4i16((LAS s16x4*)p);
    const s16x4 b = __builtin_amdgcn_ds_read_tr16_b64_v4i16((LAS s16x4*)(p + 16 * strideB));
    return (s16x8){a.x, a.y, a.z, a.w, b.x, b.y, b.z, b.w};
}
#define MFMA16(P, Q, C) __builtin_amdgcn_mfma_f32_16x16x32_bf16((P), (Q), (C), 0, 0, 0)

__device__ __forceinline__ float sum16(const float* p) {
    const f32x4 a = *(const f32x4*)p, b = *(const f32x4*)(p + 4), c = *(const f32x4*)(p + 8), d = *(const f32x4*)(p + 12);
    return (((a.x + a.y) + (a.z + a.w)) + ((b.x + b.y) + (b.z + b.w))) + (((c.x + c.y) + (c.z + c.w)) + ((d.x + d.y) + (d.z + d.w)));
}
struct EpiSwiglu {
    static constexpr bool PERM = true, AFTER_DRAIN = false;
    bf16_t* act; const float* rs;
    __device__ __forceinline__ void operator()(const f32x4 (&acc)[2][2][4][2], const pg8::Unit& u, int wr, int wc, int fr, int fq) const {
        const int row0 = u.pm * 256 + wr * 64 + fr, col0 = u.pn * 128 + wc * 32 + 8 * fq;
        float rsv[2][4];
#pragma unroll
        for (int ai = 0; ai < 2; ++ai)
#pragma unroll
            for (int m = 0; m < 4; ++m) rsv[ai][m] = rs[row0 + ai * 128 + m * 16];
#pragma unroll
        for (int ai = 0; ai < 2; ++ai)
#pragma unroll
            for (int m = 0; m < 4; ++m) {
                const int row = row0 + ai * 128 + m * 16; const float r = rsv[ai][m]; float o[8];
#pragma unroll
                for (int n = 0; n < 2; ++n)
#pragma unroll
                    for (int j = 0; j < 4; ++j) { const float g = r * acc[ai][0][m][n][j], up = r * acc[ai][1][m][n][j]; o[n * 4 + j] = silu_f(g) * up; }
                *(u32x4*)(act + (size_t)row * DFF + col0) = pack8(o);
                asm volatile("" ::: "memory");
            }
    }
};
struct EpiStoreSsq {
    static constexpr bool PERM = true, AFTER_DRAIN = false;
    bf16_t* out; float* ssq;
    __device__ __forceinline__ void operator()(const f32x4 (&acc)[2][2][4][2], const pg8::Unit& u, int wr, int wc, int fr, int fq) const {
        const int row0 = u.pm * 256 + wr * 64 + fr, col0 = u.pn * 256 + wc * 32 + 8 * fq;
#pragma unroll
        for (int ai = 0; ai < 2; ++ai)
#pragma unroll
            for (int m = 0; m < 4; ++m) {
                const int row = row0 + ai * 128 + m * 16; float s = 0.f;
#pragma unroll
                for (int bj = 0; bj < 2; ++bj) { float o[8];
#pragma unroll
                    for (int n = 0; n < 2; ++n)
#pragma unroll
                        for (int j = 0; j < 4; ++j) { const float v = acc[ai][bj][m][n][j]; o[n * 4 + j] = v; s += v * v; }
                    *(u32x4*)(out + (size_t)row * DM + col0 + bj * 128) = pack8(o); }
                s += __shfl_xor(s, 16); s += __shfl_xor(s, 32);
                if (fq == 0) ssq[(size_t)row * 16 + u.pn * 4 + wc] = s;
            }
    }
};
struct EpiProj {
    static constexpr bool PERM = true, AFTER_DRAIN = false;
    bf16_t *xa, *z, *xbc, *uu, *vv, *gates; float* dt; const float* rs; const float* dtb;
    __device__ __forceinline__ void operator()(const f32x4 (&acc)[2][2][4][2], const pg8::Unit& u, int wr, int wc, int fr, int fq) const {
        const int row0 = u.pm * 256 + wr * 64 + fr, cl = wc * 32 + 8 * fq; const int pn = u.pn;
        float rsv[2][4];
#pragma unroll
        for (int ai = 0; ai < 2; ++ai)
#pragma unroll
            for (int m = 0; m < 4; ++m) rsv[ai][m] = rs[row0 + ai * 128 + m * 16];
        if (pn == 30) {
            if (wc == 0 && fq < 2) {
#pragma unroll
                for (int ai = 0; ai < 2; ++ai)
#pragma unroll
                    for (int m = 0; m < 4; ++m) { const int row = row0 + ai * 128 + m * 16; const float r = rsv[ai][m];
#pragma unroll
                        for (int n = 0; n < 2; ++n) { f32x4 o;
#pragma unroll
                            for (int j = 0; j < 4; ++j) { const int c = 8 * fq + 4 * n + j; o[j] = softplus_f(r * acc[ai][0][m][n][j] + dtb[c]); }
                            *(f32x4*)(dt + (size_t)row * 16 + 8 * fq + 4 * n) = o; } }
            }
            return;
        }
        bf16_t* dst; int ld, c0, act;
        if (pn < 2) { dst = xa; ld = 512; c0 = pn * 256; act = 0; }
        else if (pn < 6) { dst = z; ld = 1024; c0 = (pn - 2) * 256; act = 1; }
        else if (pn < 14) { dst = xbc; ld = 2048; c0 = (pn - 6) * 256; act = 0; }
        else if (pn < 16) { dst = uu; ld = 512; c0 = (pn - 14) * 256; act = 0; }
        else if (pn < 18) { dst = vv; ld = 512; c0 = (pn - 16) * 256; act = 0; }
        else { dst = gates; ld = 3072; c0 = (pn - 18) * 256; act = 2; }
#pragma unroll
        for (int ai = 0; ai < 2; ++ai)
#pragma unroll
            for (int m = 0; m < 4; ++m) {
                const int row = row0 + ai * 128 + m * 16; const float r = rsv[ai][m];
#pragma unroll
                for (int bj = 0; bj < 2; ++bj) { float o[8];
#pragma unroll
                    for (int n = 0; n < 2; ++n)
#pragma unroll
                        for (int j = 0; j < 4; ++j) { float v = r * acc[ai][bj][m][n][j]; if (act == 1) v = silu_f(v); else if (act == 2) v = sigmoid_f(v); o[n * 4 + j] = v; }
                    *(u32x4*)(dst + (size_t)row * ld + c0 + bj * 128 + cl) = pack8(o); }
            }
    }
};
template <int MODE> struct EpiMerge {
    static constexpr bool PERM = true, AFTER_DRAIN = false;
    bf16_t* out; const bf16_t* gate; const float* ssqy;
    __device__ __forceinline__ void operator()(const f32x4 (&acc)[2][2][4][2], const pg8::Unit& u, int wr, int wc, int fr, int fq) const {
        const int row0 = u.pm * 256 + wr * 64 + fr, col0 = u.pn * 256 + wc * 32 + 8 * fq;
#pragma unroll
        for (int ai = 0; ai < 2; ++ai)
#pragma unroll
            for (int m = 0; m < 4; ++m) {
                const int row = row0 + ai * 128 + m * 16; float r = 1.f;
                if (MODE == 1) r = rsqrtf(sum16(ssqy + (size_t)row * 16) * (1.f / 1024.f) + EPS);
#pragma unroll
                for (int bj = 0; bj < 2; ++bj) {
                    float g[8], o[8]; unpack8(*(const u32x4*)(gate + (size_t)row * 3072 + col0 + bj * 128), g);
                    bf16_t* op = out + (size_t)row * DM + col0 + bj * 128;
                    if (MODE != 0) unpack8(*(const u32x4*)op, o); else {
#pragma unroll
                        for (int e = 0; e < 8; ++e) o[e] = 0.f; }
#pragma unroll
                    for (int n = 0; n < 2; ++n)
#pragma unroll
                        for (int j = 0; j < 4; ++j) o[n * 4 + j] += g[n * 4 + j] * (r * acc[ai][bj][m][n][j]);
                    *(u32x4*)op = pack8(o); }
                asm volatile("" ::: "memory");
            }
    }
};

#define XB_TMO      128
#define XB_XCNT(j)  (256  + 64 * (j))
#define XB_XSUB(j)  (1280 + 64 * (j))
#define XB_XGEN(j)  (2304 + 64 * (j))
#define XB_TOP      3328
#define XB_TOPGEN   3392
#define XCD_BAR_WORDS 3456
#define XB_SPIN_CAP (1u << 18)

__device__ __forceinline__ unsigned xb_ld(unsigned* p)              { return __hip_atomic_load(p, __ATOMIC_RELAXED, __HIP_MEMORY_SCOPE_AGENT); }
__device__ __forceinline__ unsigned xb_add(unsigned* p, unsigned v) { return __hip_atomic_fetch_add(p, v, __ATOMIC_RELAXED, __HIP_MEMORY_SCOPE_AGENT); }
__device__ __forceinline__ unsigned xb_xcc_id() { return (unsigned)__builtin_amdgcn_s_getreg((3 << 11) | 20) & 0xFu; }
#define XB_SPIN(cond, bar) do { unsigned _sp = 0; while (cond) { __builtin_amdgcn_s_sleep(1); \
    if ((++_sp & 255u) == 0u) { if (xb_ld(&(bar)[XB_TMO])) break; if (_sp > XB_SPIN_CAP) { atomicAdd(&(bar)[XB_TMO], 1u); break; } } } } while (0)

struct XcdBarrier {
    unsigned* bar; unsigned x;
    volatile LAS unsigned* st;
};

__device__ __forceinline__ XcdBarrier xcd_barrier_post(unsigned* bar, volatile LAS unsigned* st) {
    XcdBarrier b; b.bar = bar; b.x = xb_xcc_id(); b.st = st;
    if (threadIdx.x == 0) (void)xb_add(&bar[XB_XCNT(b.x)], 1u);
    return b;
}
__device__ __forceinline__ void xcd_barrier_complete(unsigned* bar, unsigned x, unsigned& nloc, unsigned& nx) {
    const unsigned G = gridDim.x * gridDim.y * gridDim.z;
    unsigned sum, cnt, mine, sp = 0u;
    for (;;) {
        sum = 0u; cnt = 0u; mine = 0u;
#pragma unroll
        for (unsigned j = 0; j < 16; ++j) { const unsigned c = xb_ld(&bar[XB_XCNT(j)]); sum += c; cnt += (c > 0u) ? 1u : 0u; mine = (j == x) ? c : mine; }
        if (sum == G) break;
        __builtin_amdgcn_s_sleep(1);
        if ((++sp & 255u) == 0u) { if (xb_ld(&bar[XB_TMO])) break; if (sp > XB_SPIN_CAP) { atomicAdd(&bar[XB_TMO], 1u); break; } }
    }
    nloc = mine > 0u ? mine : 1u; nx = cnt > 0u ? cnt : 1u;
}

__device__ __forceinline__ void xcd_barrier(const XcdBarrier& b) {
    asm volatile("s_waitcnt vmcnt(0)" ::: "memory");
    __syncthreads();
    if (threadIdx.x == 0) {
        unsigned* bar = b.bar;
        __builtin_amdgcn_s_waitcnt(0);
        unsigned nloc = b.st[0], nx = b.st[1];
        if (nloc == 0u) { xcd_barrier_complete(bar, b.x, nloc, nx); b.st[0] = nloc; b.st[1] = nx; }
        const unsigned old = xb_add(&bar[XB_XSUB(b.x)], 1u);
        const unsigned gen = old / nloc;
        if (old + 1u == (gen + 1u) * nloc) {
            __builtin_amdgcn_fence(__ATOMIC_RELEASE, "agent");
            asm volatile("s_waitcnt vmcnt(0)" ::: "memory");
            const unsigned og = xb_add(&bar[XB_TOP], 1u);
            const unsigned tg = og / nx;
            if (og + 1u == (tg + 1u) * nx) xb_add(&bar[XB_TOPGEN], 1u);
            else XB_SPIN(xb_ld(&bar[XB_TOPGEN]) == tg, bar);
            __builtin_amdgcn_fence(__ATOMIC_ACQUIRE, "agent");
            xb_add(&bar[XB_XGEN(b.x)], 1u);
            asm volatile("s_waitcnt vmcnt(0)" ::: "memory");
        } else {
            XB_SPIN(xb_ld(&bar[XB_XGEN(b.x)]) == gen, bar);
            __builtin_amdgcn_fence(__ATOMIC_ACQUIRE, "agent");
            asm volatile("s_waitcnt vmcnt(0)" ::: "memory");
        }
    }
    __syncthreads();
}

constexpr int LDS_BYTES = 147456, TAB_OFF = LDS_BYTES - 512;
struct Ctx {
    LAS unsigned char* lds; int tid, lane, wave, bid, G, ng;
    float* out; unsigned char* ws0;
    __device__ __forceinline__ const float* in(int i) const {
        const unsigned long long v = ((const LAS unsigned long long*)(lds + TAB_OFF))[i];
        const unsigned lo = __builtin_amdgcn_readfirstlane((unsigned)v), hi = __builtin_amdgcn_readfirstlane((unsigned)(v >> 32));
        return (const float*)(((unsigned long long)hi << 32) | lo);
    }
    __device__ __forceinline__ unsigned char* wsf() const { unsigned char* p = ws0; asm volatile("" : "+s"(p)); return p; }
    __device__ __forceinline__ int tidf() const { int t = tid; asm volatile("" : "+v"(t)); return t; }
    __device__ __forceinline__ int ngf() const { int n = ng; asm volatile("" : "+s"(n)); return n; }
};
struct Grp { int g, nbg, tg, row0, nrows, psoff, nsc; };
__device__ __forceinline__ Grp make_grp(int g, int ng) {
    Grp r; r.g = g; r.nbg = 8 / ng; r.tg = 65536 / ng; r.psoff = (g == 0) ? 256 : 0; r.nsc = (g == 0) ? 8 : 0;
    r.row0 = (g == 0) ? 0 : 256 + g * r.tg; r.nrows = r.tg + r.psoff; return r;
}


struct SkStoreSsq { bf16_t* out; float* ssqs;
    __device__ __forceinline__ void operator()(int row, int col0, int ct, const f32x4 v, int q) const {
        u32x2 o; o.x = pk2(v[0], v[1]); o.y = pk2(v[2], v[3]); *(u32x2*)(out + (size_t)row * DM + col0) = o;
        float s = v[0] * v[0] + v[1] * v[1] + v[2] * v[2] + v[3] * v[3]; s += __shfl_xor(s, 16); s += __shfl_xor(s, 32);
        if (q == 0) ssqs[row * 64 + ct] = s; } };
template <int MODE> struct SkMerge { bf16_t* out; const bf16_t* gate; const float* ssqy;
    __device__ __forceinline__ void operator()(int row, int col0, int ct, const f32x4 v, int q) const {
        float r = 1.f; if (MODE == 1) r = rsqrtf(sum16(ssqy + (size_t)row * 16) * (1.f / 1024.f) + EPS);
        const u32x2 gw = *(const u32x2*)(gate + (size_t)row * 3072 + col0); bf16_t* op = out + (size_t)row * DM + col0;
        float o0 = 0.f, o1 = 0.f, o2 = 0.f, o3 = 0.f;
        if (MODE != 0) { const u32x2 ow = *(const u32x2*)op; o0 = bf_lo(ow.x); o1 = bf_hi(ow.x); o2 = bf_lo(ow.y); o3 = bf_hi(ow.y); }
        o0 += bf_lo(gw.x) * (r * v[0]); o1 += bf_hi(gw.x) * (r * v[1]); o2 += bf_lo(gw.y) * (r * v[2]); o3 += bf_hi(gw.y) * (r * v[3]);
        u32x2 o; o.x = pk2(o0, o1); o.y = pk2(o2, o3); *(u32x2*)op = o; } };
template <class EpiS> __device__ __forceinline__ void skinny_gemm(const Ctx& C, const bf16_t* A, const bf16_t* Bt, int K, const EpiS& E) {
    const int tid_ = C.tidf(), lane_ = tid_ & 63, wave_ = __builtin_amdgcn_readfirstlane(tid_ >> 6), r = lane_ & 15, q = lane_ >> 4;
    const int ks = K >> 3, nst = ks >> 5;
    for (int task = C.bid; task < 256; task += C.G) {
        const int ct = task >> 2, rq = task & 3;
        f32x4 acc[2] = {(f32x4){0.f, 0.f, 0.f, 0.f}, (f32x4){0.f, 0.f, 0.f, 0.f}};
        const bf16_t* bp = Bt + (size_t)(ct * 16 + r) * K + wave_ * ks + q * 8; const bf16_t* ap = A + (size_t)(rq * 32 + r) * K + wave_ * ks + q * 8;
#pragma unroll 1
        for (int s0 = 0; s0 < nst; s0 += 4) {
            s16x8 Bf[4], A0[4], A1[4];
#pragma unroll
            for (int j = 0; j < 4; ++j) if (s0 + j < nst) { Bf[j] = *(const s16x8*)(bp + (s0 + j) * 32); A0[j] = *(const s16x8*)(ap + (s0 + j) * 32); A1[j] = *(const s16x8*)(ap + (size_t)16 * K + (s0 + j) * 32); }
#pragma unroll
            for (int j = 0; j < 4; ++j) if (s0 + j < nst) { acc[0] = MFMA16(Bf[j], A0[j], acc[0]); acc[1] = MFMA16(Bf[j], A1[j], acc[1]); }
        }
        *(LAS f32x4*)(C.lds + ((wave_ * 2 + 0) * 64 + lane_) * 16) = acc[0]; *(LAS f32x4*)(C.lds + ((wave_ * 2 + 1) * 64 + lane_) * 16) = acc[1];
        __syncthreads();
        if (wave_ < 2) {
            f32x4 v = (f32x4){0.f, 0.f, 0.f, 0.f};
#pragma unroll
            for (int w = 0; w < 8; ++w) v += *(const LAS f32x4*)(C.lds + ((w * 2 + wave_) * 64 + lane_) * 16);
            E((rq * 2 + wave_) * 16 + r, ct * 16 + 4 * q, ct, v, q);
        }
        __syncthreads();
    }
}
__device__ __forceinline__ void skinny_swiglu(const Ctx& C, const bf16_t* A, const bf16_t* Bt, const float* rs, bf16_t* act) {
    const int tid_ = C.tidf(), lane_ = tid_ & 63, wave_ = __builtin_amdgcn_readfirstlane(tid_ >> 6), r = lane_ & 15, q = lane_ >> 4;
    constexpr int K = DM, ks = K / 8, nst = ks / 32;
    for (int ct = C.bid; ct < DFF / 16; ct += C.G) {
        f32x4 ag[8], au[8];
#pragma unroll
        for (int rt = 0; rt < 8; ++rt) { ag[rt] = (f32x4){0.f, 0.f, 0.f, 0.f}; au[rt] = (f32x4){0.f, 0.f, 0.f, 0.f}; }
        const int j0 = ct * 16, brow = 256 * (j0 >> 7) + (j0 & 127) + r;
        const bf16_t* bg = Bt + (size_t)brow * K + wave_ * ks + q * 8; const bf16_t* bu = bg + (size_t)128 * K; const bf16_t* ap = A + (size_t)r * K + wave_ * ks + q * 8;
#pragma unroll 1
        for (int st = 0; st < nst; ++st) {
            const s16x8 Bg = *(const s16x8*)(bg + st * 32), Bu = *(const s16x8*)(bu + st * 32); s16x8 Af[8];
#pragma unroll
            for (int rt = 0; rt < 8; ++rt) Af[rt] = *(const s16x8*)(ap + (size_t)rt * 16 * K + st * 32);
#pragma unroll
            for (int rt = 0; rt < 8; ++rt) { ag[rt] = MFMA16(Bg, Af[rt], ag[rt]); au[rt] = MFMA16(Bu, Af[rt], au[rt]); }
        }
#pragma unroll
        for (int rt = 0; rt < 8; ++rt) { *(LAS f32x4*)(C.lds + ((wave_ * 8 + rt) * 64 + lane_) * 16) = ag[rt]; *(LAS f32x4*)(C.lds + 65536 + ((wave_ * 8 + rt) * 64 + lane_) * 16) = au[rt]; }
        __syncthreads();
        f32x4 g = (f32x4){0.f, 0.f, 0.f, 0.f}, u = (f32x4){0.f, 0.f, 0.f, 0.f};
#pragma unroll
        for (int w = 0; w < 8; ++w) { g += *(const LAS f32x4*)(C.lds + ((w * 8 + wave_) * 64 + lane_) * 16); u += *(const LAS f32x4*)(C.lds + 65536 + ((w * 8 + wave_) * 64 + lane_) * 16); }
        const int row = wave_ * 16 + r; const float rr = rs[row];
        u32x2 o; o.x = pk2(silu_f(rr * g[0]) * (rr * u[0]), silu_f(rr * g[1]) * (rr * u[1])); o.y = pk2(silu_f(rr * g[2]) * (rr * u[2]), silu_f(rr * g[3]) * (rr * u[3]));
        *(u32x2*)(act + (size_t)row * DFF + j0 + 4 * q) = o;
        __syncthreads();
    }
}

template <int MAP> __device__ __forceinline__ int wmap(int n) {
    if (MAP == 0) return n;
    if (MAP == 1) { const int blk = n >> 8, r = n & 255; return (r < 128 ? 0 : DFF) + blk * 128 + (r & 127); }
    if (n < 3584) return n; if (n < 7680) return n + 16; if (n < 7696) return 3584 + (n - 7680); return -1;
}
template <int MAP> __device__ __forceinline__ void transpose_item(const float* W, int K, int N, const float* gk, bf16_t* WT, LAS float* scr, int item, int lane, int Nd) {
    const int nblk = Nd / 64, kb = item / nblk, nb = item % nblk, k0 = 64 * kb, n0 = 64 * nb;
    const int nl = (lane & 15) * 4, kl = lane >> 4;
    const int src = wmap<MAP>(n0 + nl);
#pragma unroll 8
    for (int i = 0; i < 16; ++i) { const int kk = 4 * i + kl; f32x4 v = (f32x4){0.f, 0.f, 0.f, 0.f};
        if (src >= 0) { v = *(const f32x4*)(W + (size_t)(k0 + kk) * N + src); if (gk) v *= gk[k0 + kk]; }
        *(LAS f32x4*)(scr + kk * 68 + nl) = v; }
    asm volatile("s_waitcnt lgkmcnt(0)" ::: "memory");
    const int c = lane & 7;
#pragma unroll
    for (int j = 0; j < 8; ++j) { const int n = (lane >> 3) + 8 * j; const LAS float* sp = scr + (8 * c) * 68 + n;
        u32x4 o; o.x = pk2(sp[0 * 68], sp[1 * 68]); o.y = pk2(sp[2 * 68], sp[3 * 68]); o.z = pk2(sp[4 * 68], sp[5 * 68]); o.w = pk2(sp[6 * 68], sp[7 * 68]);
        *(u32x4*)(WT + (size_t)(n0 + n) * K + k0 + 8 * c) = o; }
    asm volatile("s_waitcnt lgkmcnt(0)" ::: "memory");
}
__device__ __forceinline__ void phase_weights(const Ctx& C, int l) {
    const int tid_ = C.tidf(), lane_ = tid_ & 63, wave_ = __builtin_amdgcn_readfirstlane(tid_ >> 6); (void)lane_; (void)wave_;
    bf16_t* WL = (bf16_t*)(C.wsf() + O_W);
    LAS float* scr = (LAS float*)(C.lds + wave_ * 17408);
    const int gw = C.bid * 8 + wave_, NGW = C.G * 8;
    const int I_GU = (DM / 64) * (NGU / 64), I_D = (DFF / 64) * (DM / 64), I_IN = (DM / 64) * (NIN / 64), I_SQ = (DM / 64) * (DM / 64), I_C = (512 / 64) * (DM / 64);
    const int total = 2 * I_GU + 2 * I_D + I_IN + 2 * I_SQ + I_C;
    for (int it = gw; it < total; it += NGW) {
        int r = it;
        if (r < I_GU) { transpose_item<1>(C.in(I_F1GU) + (size_t)l * DM * NGU, DM, NGU, C.in(I_F1PRE) + l * DM, WL + W_GU1, scr, r, lane_, NGU); continue; } r -= I_GU;
        if (r < I_GU) { transpose_item<1>(C.in(I_F2GU) + (size_t)l * DM * NGU, DM, NGU, C.in(I_F2PRE) + l * DM, WL + W_GU2, scr, r, lane_, NGU); continue; } r -= I_GU;
        if (r < I_D) { transpose_item<0>(C.in(I_F1D) + (size_t)l * DFF * DM, DFF, DM, nullptr, WL + W_D1, scr, r, lane_, DM); continue; } r -= I_D;
        if (r < I_D) { transpose_item<0>(C.in(I_F2D) + (size_t)l * DFF * DM, DFF, DM, nullptr, WL + W_D2, scr, r, lane_, DM); continue; } r -= I_D;
        if (r < I_IN) { transpose_item<2>(C.in(I_WIN) + (size_t)l * DM * 7696, DM, 7696, C.in(I_MPRE) + l * DM, WL + W_IN, scr, r, lane_, NIN); continue; } r -= I_IN;
        if (r < I_SQ) { transpose_item<0>(C.in(I_WBB) + (size_t)l * DM * DM, DM, DM, C.in(I_SSMNG) + l * DM, WL + W_B, scr, r, lane_, DM); continue; } r -= I_SQ;
        if (r < I_SQ) { transpose_item<0>(C.in(I_WOUT) + (size_t)l * DM * DM, DM, DM, nullptr, WL + W_O, scr, r, lane_, DM); continue; } r -= I_SQ;
        transpose_item<0>(C.in(I_WBC) + (size_t)l * 512 * DM, 512, DM, nullptr, WL + W_C, scr, r, lane_, DM);
    }
    const int gt = C.bid * 512 + tid_, NT = C.G * 512;
    const float* pw = C.in(I_POOLW) + (size_t)l * 4 * 128 * 128; const float* psc = C.in(I_POOLS) + l * 512; const float* wa = C.in(I_WBA) + (size_t)l * 512 * DM;
    for (int o = gt; o < 1024 * 512; o += NT) { const int cin = o >> 10, n = o & 1023, g = cin >> 7; float s = 0.f;
        const float* pr = pw + (size_t)cin * 128; const float* sr = psc + g * 128; const float* wr = wa + (size_t)(g * 128) * DM + n;
#pragma unroll 8
        for (int d = 0; d < 128; ++d) s += pr[d] * sr[d] * wr[(size_t)d * DM];
        WL[W_A + (size_t)n * 512 + cin] = (bf16_t)(pk2(s, 0.f) & 0xffffu); }
    const float* gws = C.in(I_GWS) + (size_t)l * 4 * 128 * 128;
    for (int o = gt; o < 4 * 128 * 128; o += NT) { const int t = (o >> 7) & 127, s = o & 127; WL[W_S + o] = (bf16_t)(pk2(s <= t ? gws[o] : 0.f, 0.f) & 0xffffu); }
}

__device__ __forceinline__ void phase_init_rows(const Ctx& C) {
    const int tid_ = C.tidf(), lane_ = tid_ & 63, wave_ = __builtin_amdgcn_readfirstlane(tid_ >> 6); (void)lane_; (void)wave_;
    unsigned char* wsb = C.wsf();
    bf16_t* H = (bf16_t*)(wsb + O_H); float* RS = (float*)(wsb + O_RS);
    const float* xs = C.in(I_XS); const float* xp = C.in(I_XP);
    const int gw = C.bid * 8 + wave_, NGW = C.G * 8;
    for (int r0 = gw; r0 < TOT; r0 += 2 * NGW) {
        f32x4 v[2][4]; bool act[2];
#pragma unroll
        for (int k = 0; k < 2; ++k) { const int row = r0 + k * NGW; act[k] = row < TOT;
            const float* src = !act[k] ? nullptr : (row < 128 ? xs + (size_t)row * DM : (row < 256 ? nullptr : xp + (size_t)(row - 256) * DM));
#pragma unroll
            for (int i = 0; i < 2; ++i) { const int c = i * 512 + lane_ * 8;
                v[k][2 * i] = src ? *(const f32x4*)(src + c) : (f32x4){0.f, 0.f, 0.f, 0.f}; v[k][2 * i + 1] = src ? *(const f32x4*)(src + c + 4) : (f32x4){0.f, 0.f, 0.f, 0.f}; } }
#pragma unroll
        for (int k = 0; k < 2; ++k) { const int row = r0 + k * NGW; float ss = 0.f;
#pragma unroll
            for (int i = 0; i < 2; ++i) { const int c = i * 512 + lane_ * 8; const f32x4 a = v[k][2 * i], b = v[k][2 * i + 1];
                const float f[8] = {a.x, a.y, a.z, a.w, b.x, b.y, b.z, b.w};
#pragma unroll
                for (int e = 0; e < 8; ++e) ss += f[e] * f[e];
                if (act[k]) *(u32x4*)(H + (size_t)row * DM + c) = pack8(f); }
            ss = wave_sum(ss);
            if (lane_ == 0 && act[k]) RS[row] = rsqrtf(ss * (1.f / 1024.f) + EPS); }
    }
}
__device__ __forceinline__ void phase_rowpass(const Ctx& C, int rbeg, int rcnt, const bf16_t* F, int frow0, const float* gpost, float coef, bool final) {
    const int tid_ = C.tidf(), lane_ = tid_ & 63, wave_ = __builtin_amdgcn_readfirstlane(tid_ >> 6); (void)lane_; (void)wave_;
    unsigned char* wsb = C.wsf();
    bf16_t* H = (bf16_t*)(wsb + O_H); float* RS = (float*)(wsb + O_RS); float* SSQ = (float*)(wsb + O_SSQ);
    const int gw = C.bid * 8 + wave_, NGW = C.G * 8;
    float g[2][8];
#pragma unroll
    for (int i = 0; i < 2; ++i) { const int c = i * 512 + lane_ * 8; const f32x4 ga = *(const f32x4*)(gpost + c), gb = *(const f32x4*)(gpost + c + 4);
        g[i][0] = ga.x; g[i][1] = ga.y; g[i][2] = ga.z; g[i][3] = ga.w; g[i][4] = gb.x; g[i][5] = gb.y; g[i][6] = gb.z; g[i][7] = gb.w; }
    for (int rr = gw; rr < rcnt; rr += 2 * NGW) {
        u32x4 fw[2][2], hw[2][2]; float ssum[2]; bool act[2];
#pragma unroll
        for (int k = 0; k < 2; ++k) { const int row = rbeg + rr + k * NGW; act[k] = (rr + k * NGW) < rcnt;
            if (act[k]) {
                if (row < 128) { const float* sp = (const float*)(wsb + O_SSQS) + row * 64; ssum[k] = (sum16(sp) + sum16(sp + 16)) + (sum16(sp + 32) + sum16(sp + 48)); }
                else ssum[k] = sum16(SSQ + (size_t)row * 16);
#pragma unroll
                for (int i = 0; i < 2; ++i) { const int c = i * 512 + lane_ * 8; fw[k][i] = *(const u32x4*)(F + (size_t)(row - frow0) * DM + c); hw[k][i] = *(const u32x4*)(H + (size_t)row * DM + c); } }
            else { ssum[k] = 0.f;
#pragma unroll
                for (int i = 0; i < 2; ++i) { fw[k][i] = (u32x4){0u, 0u, 0u, 0u}; hw[k][i] = (u32x4){0u, 0u, 0u, 0u}; } } }
#pragma unroll
        for (int k = 0; k < 2; ++k) { const int row = rbeg + rr + k * NGW;
            const float sc = coef * rsqrtf(ssum[k] * (1.f / 1024.f) + EPS); float ss = 0.f;
            float* orow = nullptr;
            if (final && act[k]) { if (row < 128) orow = C.out + OUT_YS + (size_t)row * DM; else if (row >= 256) orow = C.out + OUT_YP + (size_t)(row - 256) * DM; }
#pragma unroll
            for (int i = 0; i < 2; ++i) { const int c = i * 512 + lane_ * 8; float f[8], h[8]; unpack8(fw[k][i], f); unpack8(hw[k][i], h);
#pragma unroll
                for (int e = 0; e < 8; ++e) { h[e] += sc * f[e] * g[i][e]; ss += h[e] * h[e]; }
                if (act[k]) *(u32x4*)(H + (size_t)row * DM + c) = pack8(h);
                if (orow) { *(f32x4*)(orow + c) = (f32x4){h[0], h[1], h[2], h[3]}; *(f32x4*)(orow + c + 4) = (f32x4){h[4], h[5], h[6], h[7]}; } }
            ss = wave_sum(ss);
            if (lane_ == 0 && act[k]) RS[row] = rsqrtf(ss * (1.f / 1024.f) + EPS); }
    }
}

struct MixBuf { bf16_t *xa, *z, *xbc, *u, *v, *gates, *xc, *zz, *yb, *st; float *dt, *decl; };
__device__ __forceinline__ MixBuf mix_bufs(const Ctx& C) {
    const MixLay L = mix_layout(C.ngf()); unsigned char* X = C.wsf() + O_X; MixBuf b;
    b.xa = (bf16_t*)(X + L.xa); b.z = (bf16_t*)(X + L.z); b.xbc = (bf16_t*)(X + L.xbc); b.u = (bf16_t*)(X + L.u); b.v = (bf16_t*)(X + L.v); b.gates = (bf16_t*)(X + L.gates);
    b.xc = (bf16_t*)(X + L.xc); b.zz = (bf16_t*)(X + L.zz); b.yb = (bf16_t*)(X + L.yb); b.st = (bf16_t*)(X + L.xbc); b.dt = (float*)(X + L.dt); b.decl = (float*)(X + L.decl); return b;
}
__device__ __forceinline__ void tok_block(const Grp& gr, int tb, int& r0, int& b, bool& first, bool& last, int& pos0, bool& samp) {
    if (tb < gr.nsc) { r0 = 16 * tb; b = tb; first = true; last = true; pos0 = 4096; samp = true; }
    else { const int q = tb - gr.nsc, bl = q >> 9, k = q & 511; r0 = gr.psoff + bl * SEQ + 16 * k; b = gr.g * gr.nbg + bl; first = (k == 0); last = (k == 511); pos0 = 16 * k; samp = false; }
}
__device__ __forceinline__ void phase_conv(const Ctx& C, const Grp& gr, int l) {
    const int tid_ = C.tidf(), lane_ = tid_ & 63, wave_ = __builtin_amdgcn_readfirstlane(tid_ >> 6); (void)lane_; (void)wave_;
    const MixBuf B = mix_bufs(C);
    const int ntb = gr.nsc + gr.nbg * 512;
    const int c0 = (tid_ & 255) * 8;
    const float* cw = C.in(I_CONVW) + (size_t)l * 4 * 2048; const float* cb = C.in(I_CONVB) + (size_t)l * 2048;
    float w[4][8], bias[8];
#pragma unroll
    for (int k = 0; k < 4; ++k) { const f32x4 a = *(const f32x4*)(cw + k * 2048 + c0), b2 = *(const f32x4*)(cw + k * 2048 + c0 + 4); w[k][0] = a.x; w[k][1] = a.y; w[k][2] = a.z; w[k][3] = a.w; w[k][4] = b2.x; w[k][5] = b2.y; w[k][6] = b2.z; w[k][7] = b2.w; }
    { const f32x4 a = *(const f32x4*)(cb + c0), b2 = *(const f32x4*)(cb + c0 + 4); bias[0] = a.x; bias[1] = a.y; bias[2] = a.z; bias[3] = a.w; bias[4] = b2.x; bias[5] = b2.y; bias[6] = b2.z; bias[7] = b2.w; }
    for (int it = C.bid; it * 2 < ntb; it += C.G) {
        const int tb = it * 2 + (tid_ >> 8); if (tb >= ntb) continue;
        int r0, b, pos0; bool first, last, samp; tok_block(gr, tb, r0, b, first, last, pos0, samp);
        float x1[8], x2[8], x3[8];
        if (first) {
            if (samp) { const float* hs = C.in(I_SCONV) + ((size_t)(l * 8 + b) * 3) * 2048 + c0;
#pragma unroll
                for (int e = 0; e < 8; ++e) { x3[e] = hs[e]; x2[e] = hs[2048 + e]; x1[e] = hs[4096 + e]; } }
            else {
#pragma unroll
                for (int e = 0; e < 8; ++e) { x1[e] = 0.f; x2[e] = 0.f; x3[e] = 0.f; } }
        } else {
            unpack8(*(const u32x4*)(B.xbc + (size_t)(r0 - 1) * 2048 + c0), x1); unpack8(*(const u32x4*)(B.xbc + (size_t)(r0 - 2) * 2048 + c0), x2); unpack8(*(const u32x4*)(B.xbc + (size_t)(r0 - 3) * 2048 + c0), x3);
        }
        float* cout = C.out + (samp ? OUT_CONVS : OUT_CONVP) + ((size_t)(l * 8 + b) * 3) * 2048 + c0;
        u32x4 xin[16];
#pragma unroll
        for (int t = 0; t < 16; ++t) xin[t] = *(const u32x4*)(B.xbc + (size_t)(r0 + t) * 2048 + c0);
#pragma unroll
        for (int t = 0; t < 16; ++t) {
            float x0[8], o[8]; unpack8(xin[t], x0);
#pragma unroll
            for (int e = 0; e < 8; ++e) { const float a = bias[e] + w[3][e] * x0[e] + w[2][e] * x1[e] + w[1][e] * x2[e] + w[0][e] * x3[e]; o[e] = silu_f(a); }
            *(u32x4*)(B.xc + (size_t)(r0 + t) * 2048 + c0) = pack8(o);
            if (last && t >= 13) { float* p = cout + (t - 13) * 2048; *(f32x4*)p = (f32x4){x0[0], x0[1], x0[2], x0[3]}; *(f32x4*)(p + 4) = (f32x4){x0[4], x0[5], x0[6], x0[7]}; }
#pragma unroll
            for (int e = 0; e < 8; ++e) { x3[e] = x2[e]; x2[e] = x1[e]; x1[e] = x0[e]; }
        }
    }
}
template <int W> __device__ __forceinline__ void pool_block(const Ctx& C, const MixBuf& B, int l, int r0, int b, bool first, bool last, int pos0, bool samp, int c0) {
    float v0[31], v1[31];
#pragma unroll
    for (int i = 0; i < 15; ++i) {
        if (first) { if (samp) { const float* hs = C.in(I_SPOOL) + ((size_t)(l * 8 + b) * 15 + i) * 512 + c0; v0[i] = hs[0]; v1[i] = hs[1]; } else { v0[i] = 0.f; v1[i] = 0.f; } }
        else { const unsigned wv = *(const unsigned*)(B.xa + (size_t)(r0 - 15 + i) * 512 + c0); v0[i] = bf_lo(wv); v1[i] = bf_hi(wv); }
    }
#pragma unroll
    for (int t = 0; t < 16; ++t) { const unsigned wv = *(const unsigned*)(B.xa + (size_t)(r0 + t) * 512 + c0); v0[15 + t] = bf_lo(wv); v1[15 + t] = bf_hi(wv); }
    float* pout = C.out + (samp ? OUT_POOLS : OUT_POOLP) + ((size_t)(l * 8 + b) * 15) * 512 + c0;
#pragma unroll
    for (int t = 0; t < 16; ++t) {
        float s0 = 0.f, s1 = 0.f;
#pragma unroll
        for (int i = 0; i < W; ++i) { s0 += v0[15 + t - i]; s1 += v1[15 + t - i]; }
        const int cn = (pos0 + t + 1) < W ? (pos0 + t + 1) : W; const float inv = 1.f / (float)cn;
        *(unsigned*)(B.zz + (size_t)(r0 + t) * 512 + c0) = pk2(s0 * inv - v0[15 + t], s1 * inv - v1[15 + t]);
        if (last && t >= 1) { pout[(t - 1) * 512] = v0[15 + t]; pout[(t - 1) * 512 + 1] = v1[15 + t]; }
    }
}
__device__ __forceinline__ void phase_pool(const Ctx& C, const Grp& gr, int l) {
    const int tid_ = C.tidf(), lane_ = tid_ & 63, wave_ = __builtin_amdgcn_readfirstlane(tid_ >> 6); (void)lane_; (void)wave_;
    const MixBuf B = mix_bufs(C);
    const int ntb = gr.nsc + gr.nbg * 512; const int c0 = (tid_ & 255) * 2; const int wsel = (wave_ & 3);
    for (int it = (C.bid + C.G / 3) % C.G; it * 2 < ntb; it += C.G) {
        const int tb = it * 2 + (tid_ >> 8); if (tb >= ntb) continue;
        int r0, b, pos0; bool first, last, samp; tok_block(gr, tb, r0, b, first, last, pos0, samp);
        if (wsel == 0) pool_block<2>(C, B, l, r0, b, first, last, pos0, samp, c0);
        else if (wsel == 1) pool_block<4>(C, B, l, r0, b, first, last, pos0, samp, c0);
        else if (wsel == 2) pool_block<8>(C, B, l, r0, b, first, last, pos0, samp, c0);
        else pool_block<16>(C, B, l, r0, b, first, last, pos0, samp, c0);
    }
}
constexpr int VN_STRIDE = 1056;
__device__ __forceinline__ void phase_gmlp(const Ctx& C, const Grp& gr, int l) {
    const int tid_ = C.tidf(), lane_ = tid_ & 63, wave_ = __builtin_amdgcn_readfirstlane(tid_ >> 6); (void)lane_; (void)wave_;
    const MixBuf B = mix_bufs(C);
    const int nun = gr.nsc + gr.nbg * 64;
    const bf16_t* WSb = (const bf16_t*)(C.wsf() + O_W) + W_S;
    const float* gng = C.in(I_GNG) + l * 512; const float* gnb = C.in(I_GNB) + l * 512; const float* gbs = C.in(I_GBS) + l * 512;
    const int lane = lane_, r = lane & 15, q = lane >> 4;
    for (int un = (C.bid + 2 * (C.G / 3)) % C.G; un < nun; un += C.G) {
        int r0, nvalid, b; bool samp;
        if (un < gr.nsc) { r0 = 16 * un; nvalid = 16; b = un; samp = true; }
        else { const int qq = un - gr.nsc, bl = qq >> 6, k = qq & 63; r0 = gr.psoff + bl * SEQ + 128 * k; nvalid = 128; b = 0; samp = false; }
        {
            const int s = tid_ >> 2, part = tid_ & 3; const bool valid = s < nvalid;
            u32x4 raw[16]; float sum = 0.f, sq = 0.f;
#pragma unroll
            for (int i = 0; i < 16; ++i) { const int col = (i * 4 + part) * 8; raw[i] = valid ? *(const u32x4*)(B.v + (size_t)(r0 + s) * 512 + col) : (u32x4){0u, 0u, 0u, 0u};
                float f[8]; unpack8(raw[i], f);
#pragma unroll
                for (int e = 0; e < 8; ++e) { sum += f[e]; sq += f[e] * f[e]; } }
            sum += __shfl_xor(sum, 1); sum += __shfl_xor(sum, 2); sq += __shfl_xor(sq, 1); sq += __shfl_xor(sq, 2);
            const float mu = sum * (1.f / 512.f); const float var = sq * (1.f / 512.f) - mu * mu; const float rstd = rsqrtf((var > 0.f ? var : 0.f) + EPS);
            float* vout = C.out + OUT_VS + ((size_t)(l * 8 + b) * 16 + s) * 512;
#pragma unroll
            for (int i = 0; i < 16; ++i) { const int col = (i * 4 + part) * 8; float f[8]; unpack8(raw[i], f);
                const f32x4 ga = *(const f32x4*)(gng + col), gb2 = *(const f32x4*)(gng + col + 4), ba = *(const f32x4*)(gnb + col), bb = *(const f32x4*)(gnb + col + 4);
                const float g[8] = {ga.x, ga.y, ga.z, ga.w, gb2.x, gb2.y, gb2.z, gb2.w}, bt[8] = {ba.x, ba.y, ba.z, ba.w, bb.x, bb.y, bb.z, bb.w};
#pragma unroll
                for (int e = 0; e < 8; ++e) f[e] = valid ? (f[e] - mu) * rstd * g[e] + bt[e] : 0.f;
                *(LAS u32x4*)(C.lds + s * VN_STRIDE + col * 2) = pack8(f);
                if (samp && valid) { *(f32x4*)(vout + col) = (f32x4){f[0], f[1], f[2], f[3]}; *(f32x4*)(vout + col + 4) = (f32x4){f[4], f[5], f[6], f[7]}; } }
        }
        __syncthreads();
        {
            const int h = wave_ >> 1, th = wave_ & 1; const int nkb_full = (th + 1) * 2, nkb_v = (nvalid + 31) >> 5; const int nkb = (th * 64 >= nvalid) ? 0 : (nkb_full < nkb_v ? nkb_full : nkb_v);
#pragma unroll 1
            for (int chh = 0; chh < 2; ++chh) {
                f32x4 acc[4][4];
#pragma unroll
                for (int a = 0; a < 4; ++a)
#pragma unroll
                    for (int c = 0; c < 4; ++c) acc[a][c] = (f32x4){0.f, 0.f, 0.f, 0.f};
#pragma unroll 1
                for (int kb = 0; kb < nkb; ++kb) {
                    s16x8 Q[4], P[4];
#pragma unroll
                    for (int tt = 0; tt < 4; ++tt) Q[tt] = *(const s16x8*)(WSb + ((size_t)h * 128 + (th * 4 + tt) * 16 + r) * 128 + kb * 32 + q * 8);
#pragma unroll
                    for (int ct = 0; ct < 4; ++ct) P[ct] = tr_frag(C.lds, VN_STRIDE, kb * 32, h * 128 + chh * 64 + ct * 16, lane);
#pragma unroll
                    for (int ct = 0; ct < 4; ++ct)
#pragma unroll
                        for (int tt = 0; tt < 4; ++tt) acc[ct][tt] = MFMA16(P[ct], Q[tt], acc[ct][tt]);
                }
                u32x2 uq[4][4]; float bsq[4];
#pragma unroll
                for (int tt = 0; tt < 4; ++tt) { const int t = (th * 4 + tt) * 16 + r; const bool tv = t < nvalid; bsq[tt] = tv ? gbs[h * 128 + t] : 0.f;
#pragma unroll
                    for (int ct = 0; ct < 4; ++ct) uq[tt][ct] = tv ? *(const u32x2*)(B.u + (size_t)(r0 + t) * 512 + h * 128 + chh * 64 + ct * 16 + q * 4) : (u32x2){0u, 0u}; }
#pragma unroll
                for (int tt = 0; tt < 4; ++tt) { const int t = (th * 4 + tt) * 16 + r;
                    if (t < nvalid) { const float bsv = bsq[tt];
#pragma unroll
                        for (int ct = 0; ct < 4; ++ct) { const int c = h * 128 + chh * 64 + ct * 16 + q * 4; bf16_t* up = B.u + (size_t)(r0 + t) * 512 + c;
                            const u32x2 uw = uq[tt][ct]; u32x2 o;
                            o.x = pk2(bf_lo(uw.x) * (acc[ct][tt][0] + bsv), bf_hi(uw.x) * (acc[ct][tt][1] + bsv)); o.y = pk2(bf_lo(uw.y) * (acc[ct][tt][2] + bsv), bf_hi(uw.y) * (acc[ct][tt][3] + bsv));
                            *(u32x2*)up = o; } } }
            }
        }
        __syncthreads();
    }
}

constexpr int CH = 128;
__device__ __forceinline__ void ssd_chunk(const Grp& gr, int ci, int& r0, int& nvalid) {
    if (ci < gr.nsc) { r0 = 16 * ci; nvalid = 16; } else { const int qq = ci - gr.nsc, bl = qq >> 6, c = qq & 63; r0 = gr.psoff + bl * SEQ + CH * c; nvalid = CH; }
}
constexpr int XS_STRIDE = 544, BC_STRIDE = 288, BC2_STRIDE = 272;
__device__ __forceinline__ float scan64(float v, int lane) {
#pragma unroll
    for (int o = 1; o < 64; o <<= 1) { const float t = __shfl_up(v, o); if (lane >= o) v += t; }
    return v;
}
__device__ __forceinline__ void chunk_cum128(float v1, float v2, int lane, float& c1, float& c2, float& last) {
    c1 = scan64(v1, lane); const float t1 = __shfl(c1, 63); c2 = scan64(v2, lane) + t1; last = __shfl(c2, 63);
}
__device__ __forceinline__ void phase_ssd_a1(const Ctx& C, const Grp& gr, int l) {
    const int tid_ = C.tidf(), lane_ = tid_ & 63, wave_ = __builtin_amdgcn_readfirstlane(tid_ >> 6);
    const MixBuf B = mix_bufs(C);
    const int nch = gr.nsc + gr.nbg * 64, nun = nch * 4;
    const float* alog = C.in(I_ALOG) + l * 16;
    LAS unsigned char* XW = C.lds; LAS unsigned char* BS = C.lds + CH * XS_STRIDE; LAS float* wS = (LAS float*)(C.lds + CH * XS_STRIDE + CH * BC_STRIDE);
    const int lane = lane_, r = lane & 15, q = lane >> 4;
    const int nit = ((nch + 7) >> 3) * 32;
    for (int it = C.bid; it < nit; it += C.G) {
        const int ci = (it & 7) + 8 * ((it >> 3) >> 2), hg = (it >> 3) & 3; if (ci >= nch) continue;
        (void)nun; int r0, nvalid; ssd_chunk(gr, ci, r0, nvalid);
        const int nkb = (nvalid + 31) >> 5;
        u32x4 gx[8], gb[4];
        { const int ll = tid_ >> 2, quad = tid_ & 3; const bool valid = ll < nvalid;
#pragma unroll
            for (int i = 0; i < 8; ++i) gx[i] = valid ? *(const u32x4*)(B.xc + (size_t)(r0 + ll) * 2048 + hg * 256 + (i * 4 + quad) * 8) : (u32x4){0u, 0u, 0u, 0u};
#pragma unroll
            for (int j = 0; j < 4; ++j) { const int id = tid_ + j * 512, l2 = id >> 4, cb = id & 15;
                gb[j] = l2 < nvalid ? *(const u32x4*)(B.xc + (size_t)(r0 + l2) * 2048 + 1024 + hg * 128 + cb * 8) : (u32x4){0u, 0u, 0u, 0u}; } }
        if (wave_ < 4) { const int h = hg * 4 + wave_;
            const float d1 = lane < nvalid ? B.dt[(size_t)(r0 + lane) * 16 + h] : 0.f, d2 = 64 + lane < nvalid ? B.dt[(size_t)(r0 + 64 + lane) * 16 + h] : 0.f; const float a = -__expf(alog[h]);
            float c1, c2, last; chunk_cum128(d1 * a, d2 * a, lane, c1, c2, last);
            wS[wave_ * CH + lane] = __expf(last - c1) * d1; wS[wave_ * CH + 64 + lane] = __expf(last - c2) * d2;
            if (lane == 0) B.decl[ci * 16 + h] = __expf(last); }
        __syncthreads();
        { const int ll = tid_ >> 2, quad = tid_ & 3; const bool valid = ll < nvalid;
#pragma unroll
            for (int i = 0; i < 8; ++i) { const int ch = (i * 4 + quad) * 8; float f[8];
                if (valid) { unpack8(gx[i], f); const float wv = wS[(i >> 1) * CH + ll];
#pragma unroll
                    for (int e = 0; e < 8; ++e) f[e] *= wv; }
                else {
#pragma unroll
                    for (int e = 0; e < 8; ++e) f[e] = 0.f; }
                *(LAS u32x4*)(XW + ll * XS_STRIDE + ch * 2) = pack8(f); }
#pragma unroll
            for (int j = 0; j < 4; ++j) { const int id = tid_ + j * 512, l2 = id >> 4, cb = id & 15;
                *(LAS u32x4*)(BS + l2 * BC_STRIDE + cb * 16) = gb[j]; } }
        __syncthreads();
        { const int n0 = wave_ * 16; s16x8 P[4];
#pragma unroll
            for (int kb = 0; kb < 4; ++kb) P[kb] = tr_frag(BS, BC_STRIDE, kb * 32, n0, lane);
#pragma unroll
            for (int hh = 0; hh < 4; ++hh)
#pragma unroll
                for (int pt = 0; pt < 4; ++pt) { f32x4 acc = (f32x4){0.f, 0.f, 0.f, 0.f};
#pragma unroll
                    for (int kb = 0; kb < 4; ++kb) if (kb < nkb) { const s16x8 Q = tr_frag(XW, XS_STRIDE, kb * 32, hh * 64 + pt * 16, lane); acc = MFMA16(P[kb], Q, acc); }
                    u32x2 o; o.x = pk2(acc[0], acc[1]); o.y = pk2(acc[2], acc[3]);
                    *(u32x2*)(B.st + (((size_t)ci * 16 + hg * 4 + hh) * 64 + pt * 16 + r) * 128 + n0 + 4 * q) = o; } }
        __syncthreads();
    }
}
__device__ __forceinline__ void phase_ssd_a2(const Ctx& C, const Grp& gr, int l) {
    const int tid_ = C.tidf();
    const MixBuf B = mix_bufs(C);
    const int nseq = gr.nbg + gr.nsc; const int gt = C.bid * 512 + tid_, NT = C.G * 512;
    for (int it = gt; it < nseq * 32768; it += NT) {
        const int sq = it >> 15, e4 = (it & 32767) * 4, h = e4 >> 13;
        if (sq < gr.nbg) {
            const int cbase = gr.nsc + sq * 64; const int b = gr.g * gr.nbg + sq;
            float s[4] = {0.f, 0.f, 0.f, 0.f};
            u32x2 sv[16], sn[16]; float dc[16], dn[16];
#pragma unroll
            for (int j = 0; j < 16; ++j) { sv[j] = *(const u32x2*)(B.st + (size_t)(cbase + j) * 131072 + e4); dc[j] = B.decl[(cbase + j) * 16 + h]; }
#pragma unroll 1
            for (int c0 = 0; c0 < 64; c0 += 16) {
                const bool more = c0 + 16 < 64;
#pragma unroll
                for (int j = 0; j < 16; ++j) { sn[j] = more ? *(const u32x2*)(B.st + (size_t)(cbase + c0 + 16 + j) * 131072 + e4) : (u32x2){0u, 0u}; dn[j] = more ? B.decl[(cbase + c0 + 16 + j) * 16 + h] : 0.f; }
#pragma unroll
                for (int j = 0; j < 16; ++j) { u32x2 o; o.x = pk2(s[0], s[1]); o.y = pk2(s[2], s[3]); *(u32x2*)(B.st + (size_t)(cbase + c0 + j) * 131072 + e4) = o;
                    s[0] = s[0] * dc[j] + bf_lo(sv[j].x); s[1] = s[1] * dc[j] + bf_hi(sv[j].x); s[2] = s[2] * dc[j] + bf_lo(sv[j].y); s[3] = s[3] * dc[j] + bf_hi(sv[j].y); }
#pragma unroll
                for (int j = 0; j < 16; ++j) { sv[j] = sn[j]; dc[j] = dn[j]; }
            }
            *(f32x4*)(C.out + OUT_SSMP + ((size_t)(l * 8 + b)) * 131072 + e4) = (f32x4){s[0], s[1], s[2], s[3]};
        } else {
            const int b = sq - gr.nbg; const f32x4 s0 = *(const f32x4*)(C.in(I_SSSM) + ((size_t)(l * 8 + b)) * 131072 + e4);
            bf16_t* sp = B.st + (size_t)b * 131072 + e4; const u32x2 sv = *(const u32x2*)sp; const float dc = B.decl[b * 16 + h];
            u32x2 o; o.x = pk2(s0.x, s0.y); o.y = pk2(s0.z, s0.w); *(u32x2*)sp = o;
            *(f32x4*)(C.out + OUT_SSMS + ((size_t)(l * 8 + b)) * 131072 + e4) = (f32x4){s0.x * dc + bf_lo(sv.x), s0.y * dc + bf_hi(sv.x), s0.z * dc + bf_lo(sv.y), s0.w * dc + bf_hi(sv.y)};
        }
    }
}
__device__ __forceinline__ void phase_ssd_b(const Ctx& C, const Grp& gr, int l) {
    const int tid_ = C.tidf(), lane_ = tid_ & 63, wave_ = __builtin_amdgcn_readfirstlane(tid_ >> 6);
    const MixBuf B = mix_bufs(C);
    const int nch = gr.nsc + gr.nbg * 64, nun = nch * 4;
    const float* alog = C.in(I_ALOG) + l * 16; const float* dsk = C.in(I_SSMD) + l * 16; float* SSQY = (float*)(C.wsf() + O_SSQY) + (size_t)gr.row0 * 16;
    LAS unsigned char* CS = C.lds; LAS unsigned char* BS = C.lds + CH * BC2_STRIDE; LAS unsigned char* XS = C.lds + 2 * CH * BC2_STRIDE;
    LAS float* cumS = (LAS float*)(C.lds + 2 * CH * BC2_STRIDE + CH * XS_STRIDE); LAS float* dtS = cumS + 4 * CH;
    const int lane = lane_, r = lane & 15, q = lane >> 4;
    const int nit = ((nch + 7) >> 3) * 32;
    for (int it = C.bid; it < nit; it += C.G) {
        const int ci = (it & 7) + 8 * ((it >> 3) >> 2), hg = (it >> 3) & 3; if (ci >= nch) continue;
        (void)nun; int r0, nvalid; ssd_chunk(gr, ci, r0, nvalid);
        const int nlt = (nvalid + 15) >> 4;
        if (wave_ < 4) { const int h = hg * 4 + wave_;
            const float d1 = lane < nvalid ? B.dt[(size_t)(r0 + lane) * 16 + h] : 0.f, d2 = 64 + lane < nvalid ? B.dt[(size_t)(r0 + 64 + lane) * 16 + h] : 0.f; const float a = -__expf(alog[h]);
            float c1, c2, last; chunk_cum128(d1 * a, d2 * a, lane, c1, c2, last);
            cumS[wave_ * CH + lane] = c1; cumS[wave_ * CH + 64 + lane] = c2; dtS[wave_ * CH + lane] = d1; dtS[wave_ * CH + 64 + lane] = d2; }
        { const int ll = tid_ >> 2, quad = tid_ & 3; const bool valid = ll < nvalid;
#pragma unroll
            for (int i = 0; i < 8; ++i) { const int ch = (i * 4 + quad) * 8;
                const u32x4 wv = valid ? *(const u32x4*)(B.xc + (size_t)(r0 + ll) * 2048 + hg * 256 + ch) : (u32x4){0u, 0u, 0u, 0u};
                *(LAS u32x4*)(XS + ll * XS_STRIDE + ch * 2) = wv; }
#pragma unroll
            for (int j = 0; j < 4; ++j) { const int id = tid_ + j * 512, l2 = id >> 4, cb = id & 15; const bool v2 = l2 < nvalid;
                const u32x4 bv = v2 ? *(const u32x4*)(B.xc + (size_t)(r0 + l2) * 2048 + 1024 + hg * 128 + cb * 8) : (u32x4){0u, 0u, 0u, 0u};
                const u32x4 cv = v2 ? *(const u32x4*)(B.xc + (size_t)(r0 + l2) * 2048 + 1536 + hg * 128 + cb * 8) : (u32x4){0u, 0u, 0u, 0u};
                *(LAS u32x4*)(BS + l2 * BC2_STRIDE + cb * 16) = bv; *(LAS u32x4*)(CS + l2 * BC2_STRIDE + cb * 16) = cv; } }
        __syncthreads();
        { const int hh = wave_ >> 1, lh = wave_ & 1, h = hg * 4 + hh; const float dh = dsk[h];
#pragma unroll 1
          for (int ps = 0; ps < 2; ++ps) {
            const int lt0 = lh * 4 + ps * 2;
            if (lt0 >= nlt) continue;
            const int nk2 = (lt0 >> 1) + 1;
            u32x2 zq[2][4];
#pragma unroll
            for (int i = 0; i < 2; ++i) { const int lrow = (lt0 + i) * 16 + r;
#pragma unroll
                for (int pt = 0; pt < 4; ++pt) zq[i][pt] = lrow < nvalid ? *(const u32x2*)(B.z + (size_t)(r0 + lrow) * 1024 + hg * 256 + hh * 64 + pt * 16 + 4 * q) : (u32x2){0u, 0u}; }
            s16x8 Cq[2][4];
#pragma unroll
            for (int i = 0; i < 2; ++i)
#pragma unroll
                for (int kb = 0; kb < 4; ++kb) Cq[i][kb] = *(const LAS s16x8*)(CS + ((lt0 + i) * 16 + r) * BC2_STRIDE + kb * 64 + q * 16);
            s16x8 Mq[2][4];
#pragma unroll
            for (int i = 0; i < 2; ++i) { const int lrow = (lt0 + i) * 16 + r; const float cl = cumS[hh * CH + lrow];
#pragma unroll
                for (int k2 = 0; k2 < 4; ++k2) { unsigned pw[4] = {0u, 0u, 0u, 0u};
                    if (k2 < nk2) {
#pragma unroll
                    for (int s2 = 0; s2 < 2; ++s2) { const int st = k2 * 2 + s2; f32x4 cb = (f32x4){0.f, 0.f, 0.f, 0.f};
#pragma unroll
                        for (int kb = 0; kb < 4; ++kb) { const s16x8 Pb = *(const LAS s16x8*)(BS + (st * 16 + r) * BC2_STRIDE + kb * 64 + q * 16); cb = MFMA16(Pb, Cq[i][kb], cb); }
                        const f32x4 cs4 = *(const LAS f32x4*)(cumS + hh * CH + st * 16 + 4 * q), dt4 = *(const LAS f32x4*)(dtS + hh * CH + st * 16 + 4 * q);
                        float mv[4];
#pragma unroll
                        for (int jj = 0; jj < 4; ++jj) { const int sidx = st * 16 + 4 * q + jj; mv[jj] = sidx <= lrow ? cb[jj] * __expf(cl - cs4[jj]) * dt4[jj] : 0.f; }
                        pw[s2 * 2] = pk2(mv[0], mv[1]); pw[s2 * 2 + 1] = pk2(mv[2], mv[3]); } }
                    const u32x4 t4 = (u32x4){pw[0], pw[1], pw[2], pw[3]}; Mq[i][k2] = __builtin_bit_cast(s16x8, t4); } }
            f32x4 acc[4][2];
#pragma unroll
            for (int pt = 0; pt < 4; ++pt)
#pragma unroll
                for (int i = 0; i < 2; ++i) acc[pt][i] = (f32x4){0.f, 0.f, 0.f, 0.f};
#pragma unroll
            for (int pt = 0; pt < 4; ++pt)
#pragma unroll
                for (int kb = 0; kb < 4; ++kb) { const s16x8 Ps = *(const s16x8*)(B.st + (((size_t)ci * 16 + h) * 64 + pt * 16 + r) * 128 + kb * 32 + q * 8);
#pragma unroll
                    for (int i = 0; i < 2; ++i) acc[pt][i] = MFMA16(Ps, Cq[i][kb], acc[pt][i]); }
#pragma unroll
            for (int i = 0; i < 2; ++i) { const float ec = __expf(cumS[hh * CH + (lt0 + i) * 16 + r]);
#pragma unroll
                for (int pt = 0; pt < 4; ++pt) acc[pt][i] *= ec; }
#pragma unroll
            for (int pt = 0; pt < 4; ++pt)
#pragma unroll
                for (int k2 = 0; k2 < 4; ++k2) if (k2 < nk2) { const s16x8 Px = tr_frag_perm(XS, XS_STRIDE, k2 * 32, hh * 64 + pt * 16, lane);
#pragma unroll
                    for (int i = 0; i < 2; ++i) acc[pt][i] = MFMA16(Px, Mq[i][k2], acc[pt][i]); }
#pragma unroll
            for (int i = 0; i < 2; ++i) { const int lrow = (lt0 + i) * 16 + r; float ss = 0.f; const bool valid = lrow < nvalid;
#pragma unroll
                for (int pt = 0; pt < 4; ++pt) { const int chl = hh * 64 + pt * 16 + 4 * q;
                    const u32x2 xw = *(const LAS u32x2*)(XS + lrow * XS_STRIDE + chl * 2);
                    const u32x2 zw = zq[i][pt];
                    const float y0 = (acc[pt][i][0] + dh * bf_lo(xw.x)) * bf_lo(zw.x), y1 = (acc[pt][i][1] + dh * bf_hi(xw.x)) * bf_hi(zw.x),
                                y2 = (acc[pt][i][2] + dh * bf_lo(xw.y)) * bf_lo(zw.y), y3 = (acc[pt][i][3] + dh * bf_hi(xw.y)) * bf_hi(zw.y);
                    ss += y0 * y0 + y1 * y1 + y2 * y2 + y3 * y3;
                    if (valid) { u32x2 o; o.x = pk2(y0, y1); o.y = pk2(y2, y3); *(u32x2*)(B.yb + (size_t)(r0 + lrow) * 1024 + hg * 256 + chl) = o; } }
                ss += __shfl_xor(ss, 16); ss += __shfl_xor(ss, 32);
                if (q == 0 && valid) SSQY[(size_t)(r0 + lrow) * 16 + h] = ss; }
          }
        }
        __syncthreads();
    }
}

__global__ void __launch_bounds__(512, 2) mega_fwd(Params prm) {
    extern __shared__ __attribute__((aligned(16))) unsigned char lds_raw[];
    cg::grid_group grid = cg::this_grid();
    Ctx C; C.lds = (LAS unsigned char*)lds_raw; C.tid = threadIdx.x; C.lane = C.tid & 63; C.wave = __builtin_amdgcn_readfirstlane(C.tid >> 6); C.bid = blockIdx.x; C.G = gridDim.x;
    C.out = prm.out; C.ws0 = prm.ws; C.ng = prm.ng;
    if (C.tid < 32) ((LAS unsigned long long*)(C.lds + TAB_OFF))[C.tid] = (unsigned long long)prm.in[C.tid];
    if (C.tid < 2) ((volatile LAS unsigned*)(C.lds + TAB_OFF + 256))[C.tid] = 0u;
    __syncthreads();
    const XcdBarrier xbar = xcd_barrier_post((unsigned*)(prm.ws + O_BAR), (volatile LAS unsigned*)(C.lds + TAB_OFF + 256));
#define GSYNC() xcd_barrier(xbar)
#define GSYNC_CG() do { asm volatile("s_waitcnt vmcnt(0) lgkmcnt(0)" ::: "memory"); grid.sync(); } while (0)
#define GEMM_RUN(EPI, Aptr, Bptr, Mrows, Ncols, Kdim, ...) do { pg8::Gemm g_{(const bf16_t*)(Aptr), (const bf16_t*)(Bptr), (Mrows), (Ncols), (Kdim)}; pg8::StaticOrder S_; S_.init((Mrows), (Ncols), C.G, C.bid); \
        EPI E_{__VA_ARGS__}; pg8::gemm_phase<EPI, pg8::StaticOrder, true, true>(C.lds, g_, S_, E_); } while (0)
    phase_init_rows(C);
#pragma unroll 1
    for (int l = 0; l < DEPTH; ++l) {
        phase_weights(C, l);
        if (l == 0) GSYNC_CG(); else GSYNC();
        { unsigned char* w = C.wsf(); GEMM_RUN(EpiSwiglu, (bf16_t*)(w + O_H) + (size_t)256 * DM, (bf16_t*)(w + O_W) + W_GU1, 65536, NGU, DM, (bf16_t*)(w + O_X + X_ACT) + (size_t)256 * DFF, (const float*)(w + O_RS) + 256); }
        { unsigned char* w = C.wsf(); skinny_swiglu(C, (const bf16_t*)(w + O_H), (const bf16_t*)(w + O_W) + W_GU1, (const float*)(w + O_RS), (bf16_t*)(w + O_X + X_ACT)); }
        GSYNC();
        { unsigned char* w = C.wsf(); GEMM_RUN(EpiStoreSsq, (bf16_t*)(w + O_X + X_ACT) + (size_t)256 * DFF, (bf16_t*)(w + O_W) + W_D1, 65536, DM, DFF, (bf16_t*)(w + O_X + X_F) + (size_t)256 * DM, (float*)(w + O_SSQ) + 256 * 16); }
        { unsigned char* w = C.wsf(); const SkStoreSsq E{(bf16_t*)(w + O_X + X_F), (float*)(w + O_SSQS)}; skinny_gemm(C, (const bf16_t*)(w + O_X + X_ACT), (const bf16_t*)(w + O_W) + W_D1, DFF, E); }
        GSYNC();
        { unsigned char* w = C.wsf(); phase_rowpass(C, 0, TOT, (const bf16_t*)(w + O_X + X_F), 0, C.in(I_F1POST) + l * DM, 0.5f, false); }
        GSYNC();
#pragma unroll 1
        for (int gi = 0; gi < (DBG == 1 ? 0 : C.ng); ++gi) {
            const Grp gr = make_grp(gi, C.ng);
            { unsigned char* w = C.wsf(); const MixBuf MB = mix_bufs(C); GEMM_RUN(EpiProj, (bf16_t*)(w + O_H) + (size_t)gr.row0 * DM, (bf16_t*)(w + O_W) + W_IN, gr.nrows, NIN, DM, MB.xa, MB.z, MB.xbc, MB.u, MB.v, MB.gates, MB.dt, (const float*)(w + O_RS) + gr.row0, C.in(I_DTB) + l * 16); }
            GSYNC();
            phase_conv(C, gr, l);
            phase_pool(C, gr, l);
            phase_gmlp(C, gr, l);
            GSYNC();
            if (DBG != 2) { phase_ssd_a1(C, gr, l);
            GSYNC();
            phase_ssd_a2(C, gr, l);
            GSYNC();
            phase_ssd_b(C, gr, l);
            GSYNC(); }
            { unsigned char* w = C.wsf(); const MixBuf MB = mix_bufs(C); const size_t po = gr.psoff; GEMM_RUN(EpiMerge<0>, MB.zz + po * 512, (bf16_t*)(w + O_W) + W_A, gr.tg, DM, 512, MB.z + po * DM, MB.gates + po * 3072, nullptr);
              if (gr.nsc) { const SkMerge<0> E{MB.z, MB.gates, nullptr}; skinny_gemm(C, MB.zz, (const bf16_t*)(w + O_W) + W_A, 512, E); } }
            __syncthreads();
            if (DBG != 2 && DBG != 3) { unsigned char* w = C.wsf(); const MixBuf MB = mix_bufs(C); const size_t po = gr.psoff; GEMM_RUN(EpiMerge<1>, MB.yb + po * DM, (bf16_t*)(w + O_W) + W_B, gr.tg, DM, DM, MB.z + po * DM, MB.gates + po * 3072 + 1024, (const float*)(w + O_SSQY) + ((size_t)gr.row0 + po) * 16);
              if (gr.nsc) { const SkMerge<1> E{MB.z, MB.gates + 1024, (const float*)(w + O_SSQY)}; skinny_gemm(C, MB.yb, (const bf16_t*)(w + O_W) + W_B, DM, E); } }
            __syncthreads();
            { unsigned char* w = C.wsf(); const MixBuf MB = mix_bufs(C); const size_t po = gr.psoff; GEMM_RUN(EpiMerge<2>, MB.u + po * 512, (bf16_t*)(w + O_W) + W_C, gr.tg, DM, 512, MB.z + po * DM, MB.gates + po * 3072 + 2048, nullptr);
              if (gr.nsc) { const SkMerge<2> E{MB.z, MB.gates + 2048, nullptr}; skinny_gemm(C, MB.u, (const bf16_t*)(w + O_W) + W_C, 512, E); } }
            GSYNC();
            { unsigned char* w = C.wsf(); const MixBuf MB = mix_bufs(C); const size_t po = gr.psoff; GEMM_RUN(EpiStoreSsq, MB.z + po * DM, (bf16_t*)(w + O_W) + W_O, gr.tg, DM, DM, MB.yb + po * DM, (float*)(w + O_SSQ) + ((size_t)gr.row0 + po) * 16);
              if (gr.nsc) { const SkStoreSsq E{MB.yb, (float*)(w + O_SSQS)}; skinny_gemm(C, MB.z, (const bf16_t*)(w + O_W) + W_O, DM, E); } }
            GSYNC();
            { const MixBuf MB = mix_bufs(C); phase_rowpass(C, gr.row0, gr.nrows, MB.yb, gr.row0, C.in(I_MPOST) + l * DM, 1.0f, false); }
            GSYNC();
        }
        { unsigned char* w = C.wsf(); GEMM_RUN(EpiSwiglu, (bf16_t*)(w + O_H) + (size_t)256 * DM, (bf16_t*)(w + O_W) + W_GU2, 65536, NGU, DM, (bf16_t*)(w + O_X + X_ACT) + (size_t)256 * DFF, (const float*)(w + O_RS) + 256); }
        { unsigned char* w = C.wsf(); skinny_swiglu(C, (const bf16_t*)(w + O_H), (const bf16_t*)(w + O_W) + W_GU2, (const float*)(w + O_RS), (bf16_t*)(w + O_X + X_ACT)); }
        GSYNC();
        { unsigned char* w = C.wsf(); GEMM_RUN(EpiStoreSsq, (bf16_t*)(w + O_X + X_ACT) + (size_t)256 * DFF, (bf16_t*)(w + O_W) + W_D2, 65536, DM, DFF, (bf16_t*)(w + O_X + X_F) + (size_t)256 * DM, (float*)(w + O_SSQ) + 256 * 16); }
        { unsigned char* w = C.wsf(); const SkStoreSsq E{(bf16_t*)(w + O_X + X_F), (float*)(w + O_SSQS)}; skinny_gemm(C, (const bf16_t*)(w + O_X + X_ACT), (const bf16_t*)(w + O_W) + W_D2, DFF, E); }
        GSYNC();
        { unsigned char* w = C.wsf(); phase_rowpass(C, 0, TOT, (const bf16_t*)(w + O_X + X_F), 0, C.in(I_F2POST) + l * DM, 0.5f, l == DEPTH - 1); }
        GSYNC();
    }
}

extern "C" void kernel_launch(void* const* d_in, const int* in_sizes, int n_in, void* d_out, int out_size, void* d_ws, size_t ws_size, hipStream_t stream) {
    static int grid = 0, ng = 0;
    if (grid == 0) {
        int dev = 0, cus = 0, per_cu = 0;
        hipGetDevice(&dev); hipDeviceGetAttribute(&cus, hipDeviceAttributeMultiprocessorCount, dev);
        if (hipFuncSetAttribute((const void*)mega_fwd, hipFuncAttributeMaxDynamicSharedMemorySize, LDS_BYTES) != hipSuccess) { fprintf(stderr, "hipFuncSetAttribute failed\n"); grid = -1; return; }
        hipOccupancyMaxActiveBlocksPerMultiprocessor(&per_cu, (const void*)mega_fwd, 512, LDS_BYTES);
        (void)hipGetLastError();
        if (per_cu < 1) { fprintf(stderr, "occupancy query says %d blocks per CU\n", per_cu); per_cu = 1; }
        grid = cus;
        ng = 0;
        for (int c = 2; c <= 8; c *= 2) { const MixLay m = mix_layout(c); const size_t xe = m.end > X_FFN_END ? m.end : X_FFN_END; if (O_X + xe <= ws_size) { ng = c; break; } }
        if (ng == 0 || n_in != 32) { fprintf(stderr, "workspace too small (%zu) or unexpected inputs (%d)\n", ws_size, n_in); grid = -1; return; }
    }
    if (grid < 0) return;
    Params p{};
    for (int i = 0; i < 32; ++i) p.in[i] = (const float*)d_in[i];
    p.out = (float*)d_out; p.ws = (unsigned char*)d_ws; p.ng = ng; p.pad = 0;
    if (hipMemsetAsync(d_ws, 0, 65536, stream) != hipSuccess) { fprintf(stderr, "memset of barrier words failed\n"); return; }
    void* args[] = {&p};
    hipError_t e = hipLaunchCooperativeKernel((const void*)mega_fwd, dim3(grid), dim3(512), args, LDS_BYTES, stream);
    if (e != hipSuccess) fprintf(stderr, "cooperative launch failed: %s (grid %d)\n", hipGetErrorString(e), grid);
}
```

```cpp
#include <hip/hip_runtime.h>
#include <hip/hip_cooperative_groups.h>
#include <cstdio>
namespace cg = cooperative_groups;

namespace pg8 {
#define PG8_LAS __attribute__((address_space(3)))
typedef unsigned short bf16_t;
typedef short bf16x8 __attribute__((ext_vector_type(8)));
typedef float f32x4 __attribute__((ext_vector_type(4)));
typedef unsigned u32x4 __attribute__((ext_vector_type(4)));
constexpr int BM = 256, BK = 64, HALF = 128, HTB = HALF * BK * 2  , STAGE_BYTES = 8 * HTB, NXCD = 8, WGM = 4;

__host__ __device__ __forceinline__ int lds_byte(int r, int c) { const int st = (r >> 4) * 2 + (c >> 5), rr = r & 15, cc = c & 31, ob = rr * 64 + cc * 2; return st * 1024 + (ob ^ (((ob >> 9) & 1) << 5)); }
__host__ __device__ __forceinline__ void stage_rc(int b, int& R, int& C) { const int st = b / 1024, sb = b % 1024, swz = sb ^ (((sb >> 9) & 1) << 5); R = (st >> 1) * 16 + swz / 64; C = (st & 1) * 32 + (swz % 64) / 2; }
__host__ __device__ __forceinline__ int perm32(int rho) { const int n = rho >> 4, i = rho & 15; return 8 * (i >> 2) + 4 * n + (i & 3); }

struct Unit { int pm, pn; };
struct Gemm { const bf16_t* A; const bf16_t* Bt; int M, N, K; };

struct StaticOrder {
    int nM, nN, nwg, G, c;
    __host__ __device__ void init(int M, int N, int G_, int c_) { nM = M / BM; nN = N / BM; nwg = nM * nN; G = G_; c = c_; }
    __host__ __device__ bool next(int i, Unit& u) const {
        const long L = (long)i * G + c; if (L >= nwg) return false;
        int wgid = (int)L; { const int q = nwg / NXCD, r = nwg % NXCD, xcd = wgid % NXCD, off = wgid / NXCD; wgid = (xcd < r ? xcd * (q + 1) : r * (q + 1) + (xcd - r) * q) + off; }
        const int nig = WGM * nN, gid = wgid / nig, fm = gid * WGM, gsz = (nM - fm) < WGM ? (nM - fm) : WGM;
        u.pm = fm + ((wgid % nig) % gsz); u.pn = (wgid % nig) / gsz; return true;
    }
    __device__ __forceinline__ void a_ready(const Unit&) const {}
    __device__ __forceinline__ void done(const Unit&) const {}
};

__device__ __forceinline__ unsigned cvt_pk_bf16(float lo, float hi) { unsigned r; asm volatile("v_cvt_pk_bf16_f32 %0, %1, %2" : "=v"(r) : "v"(lo), "v"(hi)); return r; }
typedef float f32x2 __attribute__((ext_vector_type(2)));

template <class Epi, class Sched, bool ALIGN_EPI = false, bool SP2 = false>
__device__ __forceinline__ void gemm_phase(PG8_LAS unsigned char* lds, const Gemm g, const Sched& S, const Epi& E) {
    int tid_l = threadIdx.x; asm volatile("" : "+v"(tid_l)); const int tid = tid_l, wid = __builtin_amdgcn_readfirstlane(tid >> 6), lane = tid & 63, wr = wid >> 2, wc = wid & 3, fr = lane & 15, fq = lane >> 4;
    const int K = g.K, nt = K / BK;
    unsigned voffA[2], voffB[2];
#pragma unroll
    for (int i = 0; i < 2; ++i) { int R, C; stage_rc(tid * 16 + i * 8192, R, C); const int Rb = Epi::PERM ? ((R & ~31) + perm32(R & 31)) : R;
        voffA[i] = (unsigned)(R * K + C) * 2u; voffB[i] = (unsigned)(Rb * K + C) * 2u; }
    const size_t kstep = (size_t)(BK * 2);
    const size_t hstep = (size_t)HALF * K * 2;
    const size_t tstep = 2 * hstep;
    const unsigned ldsw = (unsigned)wid * 1024u;
    const int aoff = lds_byte(wr * 64 + fr, fq * 8), boff = lds_byte(wc * 32 + fr, fq * 8);
#define PG8_SA(b, h) (((b) * 2 + (h)) * HTB)
#define PG8_SB(b, h) ((4 + (b) * 2 + (h)) * HTB)
#define PG8_STAGE(bufoff, gbase, voff) do { _Pragma("unroll") for (int _i = 0; _i < 2; ++_i) \
        __builtin_amdgcn_global_load_lds((const unsigned*)((const char*)(gbase) + (voff)[_i]), (PG8_LAS unsigned*)(lds + (bufoff) + ldsw + _i * 8192), 16, 0, 0); } while (0)
#define PG8_LDA(dst, b, h) do { _Pragma("unroll") for (int m = 0; m < 4; ++m) _Pragma("unroll") for (int k = 0; k < 2; ++k) dst[m][k] = *(const PG8_LAS bf16x8*)(lds + PG8_SA(b, h) + aoff + m * 2048 + k * 1024); } while (0)
#define PG8_LDB(dst, b, h) do { _Pragma("unroll") for (int n = 0; n < 2; ++n) _Pragma("unroll") for (int k = 0; k < 2; ++k) dst[n][k] = *(const PG8_LAS bf16x8*)(lds + PG8_SB(b, h) + boff + n * 2048 + k * 1024); } while (0)
#define PG8_MMA(ai, bj, At, Bt) do { __builtin_amdgcn_s_setprio(1); _Pragma("unroll") for (int m = 0; m < 4; ++m) _Pragma("unroll") for (int n = 0; n < 2; ++n) _Pragma("unroll") for (int k = 0; k < 2; ++k) \
        acc[ai][bj][m][n] = __builtin_amdgcn_mfma_f32_16x16x32_bf16(Bt[n][k], At[m][k], acc[ai][bj][m][n], 0, 0, 0); __builtin_amdgcn_s_setprio(0); } while (0)
#define PG8_WAIT_V(n) asm volatile("s_waitcnt vmcnt(" #n ")" ::: "memory")
#define PG8_WAIT_L(n) asm volatile("s_waitcnt lgkmcnt(" #n ")" ::: "memory")
#define PG8_BAR __builtin_amdgcn_s_barrier()
#define PG8_SCHED __builtin_amdgcn_sched_barrier(0)
    Unit cur, nxt; int ui = 0;
    if (!S.next(0, cur)) return;
    f32x4 acc[2][2][4][2];
#pragma unroll
    for (int a = 0; a < 2; ++a)
#pragma unroll
        for (int b = 0; b < 2; ++b)
#pragma unroll
            for (int m = 0; m < 4; ++m)
#pragma unroll
                for (int n = 0; n < 2; ++n) acc[a][b][m][n] = (f32x4){0.f, 0.f, 0.f, 0.f};
    bf16x8 At[4][2], B0[2][2], B1[2][2];
    const char* cA = (const char*)g.A + (size_t)cur.pm * tstep; const char* cB = (const char*)g.Bt + (size_t)cur.pn * tstep;
    S.a_ready(cur);
    if constexpr (SP2) {
        PG8_STAGE(PG8_SB(0, 0), cB, voffB); PG8_STAGE(PG8_SB(0, 1), cB + hstep, voffB); PG8_STAGE(PG8_SA(0, 0), cA, voffA); PG8_STAGE(PG8_SA(0, 1), cA + hstep, voffA);
        if (wr == 1) PG8_BAR;
        PG8_WAIT_V(2); PG8_BAR;
        PG8_STAGE(PG8_SB(1, 0), cB + kstep, voffB); PG8_STAGE(PG8_SA(1, 0), cA + kstep, voffA); PG8_STAGE(PG8_SB(1, 1), cB + hstep + kstep, voffB);
        PG8_WAIT_V(6); PG8_BAR;
    } else {
        PG8_STAGE(PG8_SB(0, 0), cB, voffB); PG8_STAGE(PG8_SA(0, 0), cA, voffA); PG8_STAGE(PG8_SB(0, 1), cB + hstep, voffB); PG8_STAGE(PG8_SA(0, 1), cA + hstep, voffA);
        if (wr == 1) PG8_BAR;
        PG8_WAIT_V(4); PG8_BAR;
        PG8_STAGE(PG8_SB(1, 0), cB + kstep, voffB); PG8_STAGE(PG8_SA(1, 0), cA + kstep, voffA); PG8_STAGE(PG8_SB(1, 1), cB + hstep + kstep, voffB);
        PG8_WAIT_V(6); PG8_BAR;
    }
    for (;;) {
        const bool has_next = S.next(ui + 1, nxt);
        const char* nA = has_next ? (const char*)g.A + (size_t)nxt.pm * tstep : cA; const char* nB = has_next ? (const char*)g.Bt + (size_t)nxt.pn * tstep : cB;
        for (int t = 0; t < nt; t += 2) {
            const bool last = (t == nt - 2);
            const char* a1 = cA + (size_t)(t + 1) * kstep;
            const char* a2 = last ? nA : cA + (size_t)(t + 2) * kstep; const char* b2 = last ? nB : cB + (size_t)(t + 2) * kstep;
            const char* a3 = a2 + kstep; const char* b3 = b2 + kstep;
            if (last && has_next) S.a_ready(nxt);
            if constexpr (SP2) {
            PG8_LDB(B0, 0, 0); PG8_LDB(B1, 0, 1); PG8_SCHED; PG8_LDA(At, 0, 0); PG8_STAGE(PG8_SA(1, 1), a1 + hstep, voffA);
            PG8_WAIT_V(8); PG8_WAIT_L(0); PG8_BAR; PG8_MMA(0, 0, At, B0); PG8_MMA(0, 1, At, B1); PG8_BAR; PG8_SCHED;
            PG8_LDA(At, 0, 1); PG8_STAGE(PG8_SB(0, 0), b2, voffB); PG8_STAGE(PG8_SB(0, 1), b2 + hstep, voffB); PG8_STAGE(PG8_SA(0, 0), a2, voffA);
            PG8_WAIT_V(8); PG8_WAIT_L(0); PG8_BAR; PG8_MMA(1, 0, At, B0); PG8_MMA(1, 1, At, B1); PG8_BAR; PG8_SCHED;
            PG8_LDB(B0, 1, 0); PG8_LDB(B1, 1, 1); PG8_SCHED; PG8_LDA(At, 1, 0); PG8_STAGE(PG8_SA(0, 1), a2 + hstep, voffA);
            PG8_WAIT_V(8); PG8_WAIT_L(0); PG8_BAR; PG8_MMA(0, 0, At, B0); PG8_MMA(0, 1, At, B1); PG8_BAR; PG8_SCHED;
            PG8_LDA(At, 1, 1); PG8_STAGE(PG8_SB(1, 0), b3, voffB); PG8_STAGE(PG8_SB(1, 1), b3 + hstep, voffB); PG8_STAGE(PG8_SA(1, 0), a3, voffA);
            PG8_WAIT_V(8); PG8_WAIT_L(0); PG8_BAR; PG8_MMA(1, 0, At, B0); PG8_MMA(1, 1, At, B1); PG8_BAR; PG8_SCHED;
            } else {
            PG8_LDB(B0, 0, 0); PG8_SCHED; PG8_LDA(At, 0, 0); PG8_STAGE(PG8_SA(1, 1), a1 + hstep, voffA);
            PG8_WAIT_L(8); PG8_BAR; PG8_WAIT_L(0); PG8_MMA(0, 0, At, B0); PG8_BAR; PG8_SCHED;
            PG8_LDB(B1, 0, 1); PG8_STAGE(PG8_SB(0, 0), b2, voffB);
            PG8_BAR; PG8_WAIT_L(0); PG8_MMA(0, 1, At, B1); PG8_BAR;
            PG8_LDA(At, 0, 1); PG8_STAGE(PG8_SA(0, 0), a2, voffA);
            PG8_BAR; PG8_WAIT_L(0); PG8_MMA(1, 0, At, B0); PG8_BAR; PG8_SCHED;
            PG8_STAGE(PG8_SB(0, 1), b2 + hstep, voffB);
            PG8_WAIT_V(6); PG8_BAR; PG8_MMA(1, 1, At, B1); PG8_BAR;
            PG8_LDB(B0, 1, 0); PG8_SCHED; PG8_LDA(At, 1, 0); PG8_STAGE(PG8_SA(0, 1), a2 + hstep, voffA);
            PG8_WAIT_L(8); PG8_BAR; PG8_WAIT_L(0); PG8_MMA(0, 0, At, B0); PG8_BAR; PG8_SCHED;
            PG8_LDB(B1, 1, 1); PG8_STAGE(PG8_SB(1, 0), b3, voffB);
            PG8_BAR; PG8_WAIT_L(0); PG8_MMA(0, 1, At, B1); PG8_BAR;
            PG8_LDA(At, 1, 1); PG8_STAGE(PG8_SA(1, 0), a3, voffA);
            PG8_BAR; PG8_WAIT_L(0); PG8_MMA(1, 0, At, B0); PG8_BAR; PG8_SCHED;
            PG8_STAGE(PG8_SB(1, 1), b3 + hstep, voffB);
            PG8_WAIT_V(6); PG8_BAR; PG8_MMA(1, 1, At, B1); PG8_BAR;
            }
        }
        if constexpr (ALIGN_EPI) { if (wr == 0) PG8_BAR; }
        if constexpr (!Epi::AFTER_DRAIN) { E(acc, cur, wr, wc, fr, fq); S.done(cur); }
        if (!has_next) break;
#pragma unroll
        for (int a = 0; a < 2; ++a)
#pragma unroll
            for (int b = 0; b < 2; ++b)
#pragma unroll
                for (int m = 0; m < 4; ++m)
#pragma unroll
                    for (int n = 0; n < 2; ++n) acc[a][b][m][n] = (f32x4){0.f, 0.f, 0.f, 0.f};
        cur = nxt; cA = nA; cB = nB; ++ui;
        if constexpr (ALIGN_EPI) { if (wr == 1) PG8_BAR; }
    }
    PG8_WAIT_V(0);
    if constexpr (!ALIGN_EPI) { if (wr == 0) PG8_BAR; }
    PG8_BAR;
    if constexpr (Epi::AFTER_DRAIN) { E.fused(acc, cur, wr, wc, fr, fq, lds, wid, lane); S.done(cur); }
#undef PG8_SA
#undef PG8_SB
#undef PG8_STAGE
#undef PG8_LDA
#undef PG8_LDB
#undef PG8_MMA
#undef PG8_WAIT_V
#undef PG8_WAIT_L
#undef PG8_BAR
#undef PG8_SCHED
}
}


#define LAS __attribute__((address_space(3)))
typedef unsigned short bf16_t;
typedef short s16x4 __attribute__((ext_vector_type(4)));
typedef short s16x8 __attribute__((ext_vector_type(8)));
typedef float f32x4 __attribute__((ext_vector_type(4)));
typedef float f32x2 __attribute__((ext_vector_type(2)));
typedef unsigned u32x4 __attribute__((ext_vector_type(4)));
typedef unsigned u32x2 __attribute__((ext_vector_type(2)));

constexpr int DM = 1024, DFF = 2816, NGU = 5632, NIN = 7936, DEPTH = 4, SEQ = 8192;
constexpr int TOT = 65536 + 256;
constexpr float EPS = 1e-6f;
constexpr int DBG = 0;
constexpr size_t OUT_YP = 0, OUT_YS = 67108864, OUT_POOLP = 67239936, OUT_CONVP = 67485696, OUT_SSMP = 67682304,
                 OUT_POOLS = 71876608, OUT_CONVS = 72122368, OUT_SSMS = 72318976, OUT_VS = 76513280;
constexpr size_t W_GU1 = 0, W_D1 = W_GU1 + (size_t)NGU * DM, W_IN = W_D1 + (size_t)DM * DFF, W_A = W_IN + (size_t)NIN * DM, W_B = W_A + 1024 * 512,
                 W_C = W_B + 1024 * 1024, W_O = W_C + 1024 * 512, W_GU2 = W_O + 1024 * 1024, W_D2 = W_GU2 + (size_t)NGU * DM, W_S = W_D2 + (size_t)DM * DFF,
                 W_END = W_S + 4 * 128 * 128;
constexpr size_t al256(size_t x) { return (x + 255) & ~(size_t)255; }
constexpr size_t O_BAR = 0, O_SSQS = 16384  , O_H = 65536, O_RS = al256(O_H + (size_t)TOT * DM * 2), O_SSQ = al256(O_RS + TOT * 4), O_SSQY = al256(O_SSQ + TOT * 64), O_W = al256(O_SSQY + TOT * 64),
                 O_X = al256(O_W + W_END * 2);
constexpr size_t X_ACT = 0, X_F = al256((size_t)TOT * DFF * 2), X_FFN_END = X_F + (size_t)TOT * DM * 2;
struct MixLay { size_t xa, z, xbc, u, v, gates, dt, xc, zz, yb, decl, end; };
__host__ __device__ inline MixLay mix_layout(int ng) {
    const size_t RG = (size_t)(65536 / ng) + 256, nch = (size_t)(8 / ng) * 64 + 8;
    MixLay m; size_t o = 0;
    m.xa = o; o = al256(o + RG * 512 * 2);
    m.z = o; o = al256(o + RG * 1024 * 2);
    const size_t sx = RG * 2048 * 2, ss = nch * 16 * 64 * 128 * 2;
    m.xbc = o; o = al256(o + (sx > ss ? sx : ss));
    m.u = o; o = al256(o + RG * 512 * 2);
    m.v = o; o = al256(o + RG * 512 * 2);
    m.gates = o; o = al256(o + RG * 3072 * 2);
    m.dt = o; o = al256(o + RG * 16 * 4);
    m.xc = o; o = al256(o + RG * 2048 * 2);
    m.zz = o; o = al256(o + RG * 512 * 2);
    m.yb = o; o = al256(o + RG * 1024 * 2);
    m.decl = o; o = al256(o + nch * 16 * 4);
    m.end = o; return m;
}

struct Params { const float* in[32]; float* out; unsigned char* ws; int ng; int pad; };
enum { I_XP = 0, I_XS, I_SPOOL, I_SCONV, I_SSSM, I_F1PRE, I_F1POST, I_F1GU, I_F1D, I_MPRE, I_MPOST, I_WIN, I_POOLW, I_POOLS, I_CONVW, I_CONVB, I_DTB, I_ALOG, I_SSMD, I_SSMNG,
       I_GNG, I_GNB, I_GWS, I_GBS, I_WBA, I_WBB, I_WBC, I_WOUT, I_F2PRE, I_F2POST, I_F2GU, I_F2D };

__device__ __forceinline__ float bf_lo(unsigned w) { return __uint_as_float(w << 16); }
__device__ __forceinline__ float bf_hi(unsigned w) { return __uint_as_float(w & 0xffff0000u); }
typedef __bf16 bf16x2_t __attribute__((ext_vector_type(2)));
__device__ __forceinline__ unsigned pk2(float lo, float hi) { const f32x2 v = {lo, hi}; const bf16x2_t b = __builtin_convertvector(v, bf16x2_t); return __builtin_bit_cast(unsigned, b); }
__device__ __forceinline__ float sigmoid_f(float x) { return __builtin_amdgcn_rcpf(1.f + __expf(-x)); }
__device__ __forceinline__ float silu_f(float x) { return x * sigmoid_f(x); }
__device__ __forceinline__ float softplus_f(float x) { return x > 20.f ? x : log1pf(__expf(x)); }
__device__ __forceinline__ float wave_sum(float v) {
#pragma unroll
    for (int o = 1; o < 64; o <<= 1) v += __shfl_xor(v, o);
    return v;
}
__device__ __forceinline__ void unpack8(const u32x4 w, float (&f)[8]) {
    f[0] = bf_lo(w.x); f[1] = bf_hi(w.x); f[2] = bf_lo(w.y); f[3] = bf_hi(w.y); f[4] = bf_lo(w.z); f[5] = bf_hi(w.z); f[6] = bf_lo(w.w); f[7] = bf_hi(w.w);
}
__device__ __forceinline__ u32x4 pack8(const float (&f)[8]) { u32x4 w; w.x = pk2(f[0], f[1]); w.y = pk2(f[2], f[3]); w.z = pk2(f[4], f[5]); w.w = pk2(f[6], f[7]); return w; }
__device__ __forceinline__ s16x8 tr_frag(LAS unsigned char* base, int strideB, int k0, int c0, int lane) {
    const int q = lane >> 4, qq = (lane & 15) >> 2, pp = lane & 3;
    LAS unsigned char* p = base + (k0 + 8 * q + qq) * strideB + (c0 + 4 * pp) * 2;
    const s16x4 a = __builtin_amdgcn_ds_read_tr16_b64_v4i16((LAS s16x4*)p);
    const s16x4 b = __builtin_amdgcn_ds_read_tr16_b64_v4i16((LAS s16x4*)(p + 4 * strideB));
    return (s16x8){a.x, a.y, a.z, a.w, b.x, b.y, b.z, b.w};
}
__device__ __forceinline__ s16x8 tr_frag_perm(LAS unsigned char* base, int strideB, int k0, int c0, int lane) {
    const int q = lane >> 4, qq = (lane & 15) >> 2, pp = lane & 3;
    LAS unsigned char* p = base + (k0 + 4 * q + qq) * strideB + (c0 + 4 * pp) * 2;
    const s16x4 a = __builtin_amdgcn_ds_read_tr16_b64_v4i16((LAS s16x4*)p);
    const s16x4 b = __builtin_amdgcn_ds_read_tr16_b64_v4i16((LAS s16x4*)(p + 16 * strideB));
    return (s16x8){a.x, a.y, a.z, a.w, b.x, b.y, b.z, b.w};
}
#define MFMA16(P, Q, C) __builtin_amdgcn_mfma_f32_16x16x32_bf16((P), (Q), (C), 0, 0, 0)

__device__ __forceinline__ float sum16(const float* p) {
    const f32x4 a = *(const f32x4*)p, b = *(const f32x4*)(p + 4), c = *(const f32x4*)(p + 8), d = *(const f32x4*)(p + 12);
    return (((a.x + a.y) + (a.z + a.w)) + ((b.x + b.y) + (b.z + b.w))) + (((c.x + c.y) + (c.z + c.w)) + ((d.x + d.y) + (d.z + d.w)));
}
struct EpiSwiglu {
    static constexpr bool PERM = true, AFTER_DRAIN = false;
    bf16_t* act; const float* rs;
    __device__ __forceinline__ void operator()(const f32x4 (&acc)[2][2][4][2], const pg8::Unit& u, int wr, int wc, int fr, int fq) const {
        const int row0 = u.pm * 256 + wr * 64 + fr, col0 = u.pn * 128 + wc * 32 + 8 * fq;
        float rsv[2][4];
#pragma unroll
        for (int ai = 0; ai < 2; ++ai)
#pragma unroll
            for (int m = 0; m < 4; ++m) rsv[ai][m] = rs[row0 + ai * 128 + m * 16];
#pragma unroll
        for (int ai = 0; ai < 2; ++ai)
#pragma unroll
            for (int m = 0; m < 4; ++m) {
                const int row = row0 + ai * 128 + m * 16; const float r = rsv[ai][m]; float o[8];
#pragma unroll
                for (int n = 0; n < 2; ++n)
#pragma unroll
                    for (int j = 0; j < 4; ++j) { const float g = r * acc[ai][0][m][n][j], up = r * acc[ai][1][m][n][j]; o[n * 4 + j] = silu_f(g) * up; }
                *(u32x4*)(act + (size_t)row * DFF + col0) = pack8(o);
                asm volatile("" ::: "memory");
            }
    }
};
struct EpiStoreSsq {
    static constexpr bool PERM = true, AFTER_DRAIN = false;
    bf16_t* out; float* ssq;
    __device__ __forceinline__ void operator()(const f32x4 (&acc)[2][2][4][2], const pg8::Unit& u, int wr, int wc, int fr, int fq) const {
        const int row0 = u.pm * 256 + wr * 64 + fr, col0 = u.pn * 256 + wc * 32 + 8 * fq;
#pragma unroll
        for (int ai = 0; ai < 2; ++ai)
#pragma unroll
            for (int m = 0; m < 4; ++m) {
                const int row = row0 + ai * 128 + m * 16; float s = 0.f;
#pragma unroll
                for (int bj = 0; bj < 2; ++bj) { float o[8];
#pragma unroll
                    for (int n = 0; n < 2; ++n)
#pragma unroll
                        for (int j = 0; j < 4; ++j) { const float v = acc[ai][bj][m][n][j]; o[n * 4 + j] = v; s += v * v; }
                    *(u32x4*)(out + (size_t)row * DM + col0 + bj * 128) = pack8(o); }
                s += __shfl_xor(s, 16); s += __shfl_xor(s, 32);
                if (fq == 0) ssq[(size_t)row * 16 + u.pn * 4 + wc] = s;
            }
    }
};
struct EpiProj {
    static constexpr bool PERM = true, AFTER_DRAIN = false;
    bf16_t *xa, *z, *xbc, *uu, *vv, *gates; float* dt; const float* rs; const float* dtb;
    __device__ __forceinline__ void operator()(const f32x4 (&acc)[2][2][4][2], const pg8::Unit& u, int wr, int wc, int fr, int fq) const {
        const int row0 = u.pm * 256 + wr * 64 + fr, cl = wc * 32 + 8 * fq; const int pn = u.pn;
        float rsv[2][4];
#pragma unroll
        for (int ai = 0; ai < 2; ++ai)
#pragma unroll
            for (int m = 0; m < 4; ++m) rsv[ai][m] = rs[row0 + ai * 128 + m * 16];
        if (pn == 30) {
            if (wc == 0 && fq < 2) {
#pragma unroll
                for (int ai = 0; ai < 2; ++ai)
#pragma unroll
                    for (int m = 0; m < 4; ++m) { const int row = row0 + ai * 128 + m * 16; const float r = rsv[ai][m];
#pragma unroll
                        for (int n = 0; n < 2; ++n) { f32x4 o;
#pragma unroll
                            for (int j = 0; j < 4; ++j) { const int c = 8 * fq + 4 * n + j; o[j] = softplus_f(r * acc[ai][0][m][n][j] + dtb[c]); }
                            *(f32x4*)(dt + (size_t)row * 16 + 8 * fq + 4 * n) = o; } }
            }
            return;
        }
        bf16_t* dst; int ld, c0, act;
        if (pn < 2) { dst = xa; ld = 512; c0 = pn * 256; act = 0; }
        else if (pn < 6) { dst = z; ld = 1024; c0 = (pn - 2) * 256; act = 1; }
        else if (pn < 14) { dst = xbc; ld = 2048; c0 = (pn - 6) * 256; act = 0; }
        else if (pn < 16) { dst = uu; ld = 512; c0 = (pn - 14) * 256; act = 0; }
        else if (pn < 18) { dst = vv; ld = 512; c0 = (pn - 16) * 256; act = 0; }
        else { dst = gates; ld = 3072; c0 = (pn - 18) * 256; act = 2; }
#pragma unroll
        for (int ai = 0; ai < 2; ++ai)
#pragma unroll
            for (int m = 0; m < 4; ++m) {
                const int row = row0 + ai * 128 + m * 16; const float r = rsv[ai][m];
#pragma unroll
                for (int bj = 0; bj < 2; ++bj) { float o[8];
#pragma unroll
                    for (int n = 0; n < 2; ++n)
#pragma unroll
                        for (int j = 0; j < 4; ++j) { float v = r * acc[ai][bj][m][n][j]; if (act == 1) v = silu_f(v); else if (act == 2) v = sigmoid_f(v); o[n * 4 + j] = v; }
                    *(u32x4*)(dst + (size_t)row * ld + c0 + bj * 128 + cl) = pack8(o); }
            }
    }
};
template <int MODE> struct EpiMerge {
    static constexpr bool PERM = true, AFTER_DRAIN = false;
    bf16_t* out; const bf16_t* gate; const float* ssqy;
    __device__ __forceinline__ void operator()(const f32x4 (&acc)[2][2][4][2], const pg8::Unit& u, int wr, int wc, int fr, int fq) const {
        const int row0 = u.pm * 256 + wr * 64 + fr, col0 = u.pn * 256 + wc * 32 + 8 * fq;
#pragma unroll
        for (int ai = 0; ai < 2; ++ai)
#pragma unroll
            for (int m = 0; m < 4; ++m) {
                const int row = row0 + ai * 128 + m * 16; float r = 1.f;
                if (MODE == 1) r = rsqrtf(sum16(ssqy + (size_t)row * 16) * (1.f / 1024.f) + EPS);
#pragma unroll
                for (int bj = 0; bj < 2; ++bj) {
                    float g[8], o[8]; unpack8(*(const u32x4*)(gate + (size_t)row * 3072 + col0 + bj * 128), g);
                    bf16_t* op = out + (size_t)row * DM + col0 + bj * 128;
                    if (MODE != 0) unpack8(*(const u32x4*)op, o); else {
#pragma unroll
                        for (int e = 0; e < 8; ++e) o[e] = 0.f; }
#pragma unroll
                    for (int n = 0; n < 2; ++n)
#pragma unroll
                        for (int j = 0; j < 4; ++j) o[n * 4 + j] += g[n * 4 + j] * (r * acc[ai][bj][m][n][j]);
                    *(u32x4*)op = pack8(o); }
                asm volatile("" ::: "memory");
            }
    }
};

#define XB_TMO      128
#define XB_XCNT(j)  (256  + 64 * (j))
#define XB_XSUB(j)  (1280 + 64 * (j))
#define XB_XGEN(j)  (2304 + 64 * (j))
#define XB_TOP      3328
#define XB_TOPGEN   3392
#define XCD_BAR_WORDS 3456
#define XB_SPIN_CAP (1u << 18)

__device__ __forceinline__ unsigned xb_ld(unsigned* p)              { return __hip_atomic_load(p, __ATOMIC_RELAXED, __HIP_MEMORY_SCOPE_AGENT); }
__device__ __forceinline__ unsigned xb_add(unsigned* p, unsigned v) { return __hip_atomic_fetch_add(p, v, __ATOMIC_RELAXED, __HIP_MEMORY_SCOPE_AGENT); }
__device__ __forceinline__ unsigned xb_xcc_id() { return (unsigned)__builtin_amdgcn_s_getreg((3 << 11) | 20) & 0xFu; }
#define XB_SPIN(cond, bar) do { unsigned _sp = 0; while (cond) { __builtin_amdgcn_s_sleep(1); \
    if ((++_sp & 255u) == 0u) { if (xb_ld(&(bar)[XB_TMO])) break; if (_sp > XB_SPIN_CAP) { atomicAdd(&(bar)[XB_TMO], 1u); break; } } } } while (0)

struct XcdBarrier {
    unsigned* bar; unsigned x;
    volatile LAS unsigned* st;
};

__device__ __forceinline__ XcdBarrier xcd_barrier_post(unsigned* bar, volatile LAS unsigned* st) {
    XcdBarrier b; b.bar = bar; b.x = xb_xcc_id(); b.st = st;
    if (threadIdx.x == 0) (void)xb_add(&bar[XB_XCNT(b.x)], 1u);
    return b;
}
__device__ __forceinline__ void xcd_barrier_complete(unsigned* bar, unsigned x, unsigned& nloc, unsigned& nx) {
    const unsigned G = gridDim.x * gridDim.y * gridDim.z;
    unsigned sum, cnt, mine, sp = 0u;
    for (;;) {
        sum = 0u; cnt = 0u; mine = 0u;
#pragma unroll
        for (unsigned j = 0; j < 16; ++j) { const unsigned c = xb_ld(&bar[XB_XCNT(j)]); sum += c; cnt += (c > 0u) ? 1u : 0u; mine = (j == x) ? c : mine; }
        if (sum == G) break;
        __builtin_amdgcn_s_sleep(1);
        if ((++sp & 255u) == 0u) { if (xb_ld(&bar[XB_TMO])) break; if (sp > XB_SPIN_CAP) { atomicAdd(&bar[XB_TMO], 1u); break; } }
    }
    nloc = mine > 0u ? mine : 1u; nx = cnt > 0u ? cnt : 1u;
}

__device__ __forceinline__ void xcd_barrier(const XcdBarrier& b) {
    asm volatile("s_waitcnt vmcnt(0)" ::: "memory");
    __syncthreads();
    if (threadIdx.x == 0) {
        unsigned* bar = b.bar;
        __builtin_amdgcn_s_waitcnt(0);
        unsigned nloc = b.st[0], nx = b.st[1];
        if (nloc == 0u) { xcd_barrier_complete(bar, b.x, nloc, nx); b.st[0] = nloc; b.st[1] = nx; }
        const unsigned old = xb_add(&bar[XB_XSUB(b.x)], 1u);
        const unsigned gen = old / nloc;
        if (old + 1u == (gen + 1u) * nloc) {
            __builtin_amdgcn_fence(__ATOMIC_RELEASE, "agent");
            asm volatile("s_waitcnt vmcnt(0)" ::: "memory");
            const unsigned og = xb_add(&bar[XB_TOP], 1u);
            const unsigned tg = og / nx;
            if (og + 1u == (tg + 1u) * nx) xb_add(&bar[XB_TOPGEN], 1u);
            else XB_SPIN(xb_ld(&bar[XB_TOPGEN]) == tg, bar);
            __builtin_amdgcn_fence(__ATOMIC_ACQUIRE, "agent");
            xb_add(&bar[XB_XGEN(b.x)], 1u);
            asm volatile("s_waitcnt vmcnt(0)" ::: "memory");
        } else {
            XB_SPIN(xb_ld(&bar[XB_XGEN(b.x)]) == gen, bar);
            __builtin_amdgcn_fence(__ATOMIC_ACQUIRE, "agent");
            asm volatile("s_waitcnt vmcnt(0)" ::: "memory");
        }
    }
    __syncthreads();
}

constexpr int LDS_BYTES = 147456, TAB_OFF = LDS_BYTES - 512;
struct Ctx {
    LAS unsigned char* lds; int tid, lane, wave, bid, G, ng;
    float* out; unsigned char* ws0;
    __device__ __forceinline__ const float* in(int i) const {
        const unsigned long long v = ((const LAS unsigned long long*)(lds + TAB_OFF))[i];
        const unsigned lo = __builtin_amdgcn_readfirstlane((unsigned)v), hi = __builtin_amdgcn_readfirstlane((unsigned)(v >> 32));
        return (const float*)(((unsigned long long)hi << 32) | lo);
    }
    __device__ __forceinline__ unsigned char* wsf() const { unsigned char* p = ws0; asm volatile("" : "+s"(p)); return p; }
    __device__ __forceinline__ int tidf() const { int t = tid; asm volatile("" : "+v"(t)); return t; }
    __device__ __forceinline__ int ngf() const { int n = ng; asm volatile("" : "+s"(n)); return n; }
};
struct Grp { int g, nbg, tg, row0, nrows, psoff, nsc; };
__device__ __forceinline__ Grp make_grp(int g, int ng) {
    Grp r; r.g = g; r.nbg = 8 / ng; r.tg = 65536 / ng; r.psoff = (g == 0) ? 256 : 0; r.nsc = (g == 0) ? 8 : 0;
    r.row0 = (g == 0) ? 0 : 256 + g * r.tg; r.nrows = r.tg + r.psoff; return r;
}


struct SkStoreSsq { bf16_t* out; float* ssqs;
    __device__ __forceinline__ void operator()(int row, int col0, int ct, const f32x4 v, int q) const {
        u32x2 o; o.x = pk2(v[0], v[1]); o.y = pk2(v[2], v[3]); *(u32x2*)(out + (size_t)row * DM + col0) = o;
        float s = v[0] * v[0] + v[1] * v[1] + v[2] * v[2] + v[3] * v[3]; s += __shfl_xor(s, 16); s += __shfl_xor(s, 32);
        if (q == 0) ssqs[row * 64 + ct] = s; } };
template <int MODE> struct SkMerge { bf16_t* out; const bf16_t* gate; const float* ssqy;
    __device__ __forceinline__ void operator()(int row, int col0, int ct, const f32x4 v, int q) const {
        float r = 1.f; if (MODE == 1) r = rsqrtf(sum16(ssqy + (size_t)row * 16) * (1.f / 1024.f) + EPS);
        const u32x2 gw = *(const u32x2*)(gate + (size_t)row * 3072 + col0); bf16_t* op = out + (size_t)row * DM + col0;
        float o0 = 0.f, o1 = 0.f, o2 = 0.f, o3 = 0.f;
        if (MODE != 0) { const u32x2 ow = *(const u32x2*)op; o0 = bf_lo(ow.x); o1 = bf_hi(ow.x); o2 = bf_lo(ow.y); o3 = bf_hi(ow.y); }
        o0 += bf_lo(gw.x) * (r * v[0]); o1 += bf_hi(gw.x) * (r * v[1]); o2 += bf_lo(gw.y) * (r * v[2]); o3 += bf_hi(gw.y) * (r * v[3]);
        u32x2 o; o.x = pk2(o0, o1); o.y = pk2(o2, o3); *(u32x2*)op = o; } };
template <class EpiS> __device__ __forceinline__ void skinny_gemm(const Ctx& C, const bf16_t* A, const bf16_t* Bt, int K, const EpiS& E) {
    const int tid_ = C.tidf(), lane_ = tid_ & 63, wave_ = __builtin_amdgcn_readfirstlane(tid_ >> 6), r = lane_ & 15, q = lane_ >> 4;
    const int ks = K >> 3, nst = ks >> 5;
    for (int task = C.bid; task < 256; task += C.G) {
        const int ct = task >> 2, rq = task & 3;
        f32x4 acc[2] = {(f32x4){0.f, 0.f, 0.f, 0.f}, (f32x4){0.f, 0.f, 0.f, 0.f}};
        const bf16_t* bp = Bt + (size_t)(ct * 16 + r) * K + wave_ * ks + q * 8; const bf16_t* ap = A + (size_t)(rq * 32 + r) * K + wave_ * ks + q * 8;
#pragma unroll 1
        for (int s0 = 0; s0 < nst; s0 += 4) {
            s16x8 Bf[4], A0[4], A1[4];
#pragma unroll
            for (int j = 0; j < 4; ++j) if (s0 + j < nst) { Bf[j] = *(const s16x8*)(bp + (s0 + j) * 32); A0[j] = *(const s16x8*)(ap + (s0 + j) * 32); A1[j] = *(const s16x8*)(ap + (size_t)16 * K + (s0 + j) * 32); }
#pragma unroll
            for (int j = 0; j < 4; ++j) if (s0 + j < nst) { acc[0] = MFMA16(Bf[j], A0[j], acc[0]); acc[1] = MFMA16(Bf[j], A1[j], acc[1]); }
        }
        *(LAS f32x4*)(C.lds + ((wave_ * 2 + 0) * 64 + lane_) * 16) = acc[0]; *(LAS f32x4*)(C.lds + ((wave_ * 2 + 1) * 64 + lane_) * 16) = acc[1];
        __syncthreads();
        if (wave_ < 2) {
            f32x4 v = (f32x4){0.f, 0.f, 0.f, 0.f};
#pragma unroll
            for (int w = 0; w < 8; ++w) v += *(const LAS f32x4*)(C.lds + ((w * 2 + wave_) * 64 + lane_) * 16);
            E((rq * 2 + wave_) * 16 + r, ct * 16 + 4 * q, ct, v, q);
        }
        __syncthreads();
    }
}
__device__ __forceinline__ void skinny_swiglu(const Ctx& C, const bf16_t* A, const bf16_t* Bt, const float* rs, bf16_t* act) {
    const int tid_ = C.tidf(), lane_ = tid_ & 63, wave_ = __builtin_amdgcn_readfirstlane(tid_ >> 6), r = lane_ & 15, q = lane_ >> 4;
    constexpr int K = DM, ks = K / 8, nst = ks / 32;
    for (int ct = C.bid; ct < DFF / 16; ct += C.G) {
        f32x4 ag[8], au[8];
#pragma unroll
        for (int rt = 0; rt < 8; ++rt) { ag[rt] = (f32x4){0.f, 0.f, 0.f, 0.f}; au[rt] = (f32x4){0.f, 0.f, 0.f, 0.f}; }
        const int j0 = ct * 16, brow = 256 * (j0 >> 7) + (j0 & 127) + r;
        const bf16_t* bg = Bt + (size_t)brow * K + wave_ * ks + q * 8; const bf16_t* bu = bg + (size_t)128 * K; const bf16_t* ap = A + (size_t)r * K + wave_ * ks + q * 8;
#pragma unroll 1
        for (int st = 0; st < nst; ++st) {
            const s16x8 Bg = *(const s16x8*)(bg + st * 32), Bu = *(const s16x8*)(bu + st * 32); s16x8 Af[8];
#pragma unroll
            for (int rt = 0; rt < 8; ++rt) Af[rt] = *(const s16x8*)(ap + (size_t)rt * 16 * K + st * 32);
#pragma unroll
            for (int rt = 0; rt < 8; ++rt) { ag[rt] = MFMA16(Bg, Af[rt], ag[rt]); au[rt] = MFMA16(Bu, Af[rt], au[rt]); }
        }
#pragma unroll
        for (int rt = 0; rt < 8; ++rt) { *(LAS f32x4*)(C.lds + ((wave_ * 8 + rt) * 64 + lane_) * 16) = ag[rt]; *(LAS f32x4*)(C.lds + 65536 + ((wave_ * 8 + rt) * 64 + lane_) * 16) = au[rt]; }
        __syncthreads();
        f32x4 g = (f32x4){0.f, 0.f, 0.f, 0.f}, u = (f32x4){0.f, 0.f, 0.f, 0.f};
#pragma unroll
        for (int w = 0; w < 8; ++w) { g += *(const LAS f32x4*)(C.lds + ((w * 8 + wave_) * 64 + lane_) * 16); u += *(const LAS f32x4*)(C.lds + 65536 + ((w * 8 + wave_) * 64 + lane_) * 16); }
        const int row = wave_ * 16 + r; const float rr = rs[row];
        u32x2 o; o.x = pk2(silu_f(rr * g[0]) * (rr * u[0]), silu_f(rr * g[1]) * (rr * u[1])); o.y = pk2(silu_f(rr * g[2]) * (rr * u[2]), silu_f(rr * g[3]) * (rr * u[3]));
        *(u32x2*)(act + (size_t)row * DFF + j0 + 4 * q) = o;
        __syncthreads();
    }
}

template <int MAP> __device__ __forceinline__ int wmap(int n) {
    if (MAP == 0) return n;
    if (MAP == 1) { const int blk = n >> 8, r = n & 255; return (r < 128 ? 0 : DFF) + blk * 128 + (r & 127); }
    if (n < 3584) return n; if (n < 7680) return n + 16; if (n < 7696) return 3584 + (n - 7680); return -1;
}
template <int MAP> __device__ __forceinline__ void transpose_item(const float* W, int K, int N, const float* gk, bf16_t* WT, LAS float* scr, int item, int lane, int Nd) {
    const int nblk = Nd / 64, kb = item / nblk, nb = item % nblk, k0 = 64 * kb, n0 = 64 * nb;
    const int nl = (lane & 15) * 4, kl = lane >> 4;
    const int src = wmap<MAP>(n0 + nl);
#pragma unroll 8
    for (int i = 0; i < 16; ++i) { const int kk = 4 * i + kl; f32x4 v = (f32x4){0.f, 0.f, 0.f, 0.f};
        if (src >= 0) { v = *(const f32x4*)(W + (size_t)(k0 + kk) * N + src); if (gk) v *= gk[k0 + kk]; }
        *(LAS f32x4*)(scr + kk * 68 + nl) = v; }
    asm volatile("s_waitcnt lgkmcnt(0)" ::: "memory");
    const int c = lane & 7;
#pragma unroll
    for (int j = 0; j < 8; ++j) { const int n = (lane >> 3) + 8 * j; const LAS float* sp = scr + (8 * c) * 68 + n;
        u32x4 o; o.x = pk2(sp[0 * 68], sp[1 * 68]); o.y = pk2(sp[2 * 68], sp[3 * 68]); o.z = pk2(sp[4 * 68], sp[5 * 68]); o.w = pk2(sp[6 * 68], sp[7 * 68]);
        *(u32x4*)(WT + (size_t)(n0 + n) * K + k0 + 8 * c) = o; }
    asm volatile("s_waitcnt lgkmcnt(0)" ::: "memory");
}
__device__ __forceinline__ void phase_weights(const Ctx& C, int l) {
    const int tid_ = C.tidf(), lane_ = tid_ & 63, wave_ = __builtin_amdgcn_readfirstlane(tid_ >> 6); (void)lane_; (void)wave_;
    bf16_t* WL = (bf16_t*)(C.wsf() + O_W);
    LAS float* scr = (LAS float*)(C.lds + wave_ * 17408);
    const int gw = C.bid * 8 + wave_, NGW = C.G * 8;
    const int I_GU = (DM / 64) * (NGU / 64), I_D = (DFF / 64) * (DM / 64), I_IN = (DM / 64) * (NIN / 64), I_SQ = (DM / 64) * (DM / 64), I_C = (512 / 64) * (DM / 64);
    const int total = 2 * I_GU + 2 * I_D + I_IN + 2 * I_SQ + I_C;
    for (int it = gw; it < total; it += NGW) {
        int r = it;
        if (r < I_GU) { transpose_item<1>(C.in(I_F1GU) + (size_t)l * DM * NGU, DM, NGU, C.in(I_F1PRE) + l * DM, WL + W_GU1, scr, r, lane_, NGU); continue; } r -= I_GU;
        if (r < I_GU) { transpose_item<1>(C.in(I_F2GU) + (size_t)l * DM * NGU, DM, NGU, C.in(I_F2PRE) + l * DM, WL + W_GU2, scr, r, lane_, NGU); continue; } r -= I_GU;
        if (r < I_D) { transpose_item<0>(C.in(I_F1D) + (size_t)l * DFF * DM, DFF, DM, nullptr, WL + W_D1, scr, r, lane_, DM); continue; } r -= I_D;
        if (r < I_D) { transpose_item<0>(C.in(I_F2D) + (size_t)l * DFF * DM, DFF, DM, nullptr, WL + W_D2, scr, r, lane_, DM); continue; } r -= I_D;
        if (r < I_IN) { transpose_item<2>(C.in(I_WIN) + (size_t)l * DM * 7696, DM, 7696, C.in(I_MPRE) + l * DM, WL + W_IN, scr, r, lane_, NIN); continue; } r -= I_IN;
        if (r < I_SQ) { transpose_item<0>(C.in(I_WBB) + (size_t)l * DM * DM, DM, DM, C.in(I_SSMNG) + l * DM, WL + W_B, scr, r, lane_, DM); continue; } r -= I_SQ;
        if (r < I_SQ) { transpose_item<0>(C.in(I_WOUT) + (size_t)l * DM * DM, DM, DM, nullptr, WL + W_O, scr, r, lane_, DM); continue; } r -= I_SQ;
        transpose_item<0>(C.in(I_WBC) + (size_t)l * 512 * DM, 512, DM, nullptr, WL + W_C, scr, r, lane_, DM);
    }
    const int gt = C.bid * 512 + tid_, NT = C.G * 512;
    const float* pw = C.in(I_POOLW) + (size_t)l * 4 * 128 * 128; const float* psc = C.in(I_POOLS) + l * 512; const float* wa = C.in(I_WBA) + (size_t)l * 512 * DM;
    for (int o = gt; o < 1024 * 512; o += NT) { const int cin = o >> 10, n = o & 1023, g = cin >> 7; float s = 0.f;
        const float* pr = pw + (size_t)cin * 128; const float* sr = psc + g * 128; const float* wr = wa + (size_t)(g * 128) * DM + n;
#pragma unroll 8
        for (int d = 0; d < 128; ++d) s += pr[d] * sr[d] * wr[(size_t)d * DM];
        WL[W_A + (size_t)n * 512 + cin] = (bf16_t)(pk2(s, 0.f) & 0xffffu); }
    const float* gws = C.in(I_GWS) + (size_t)l * 4 * 128 * 128;
    for (int o = gt; o < 4 * 128 * 128; o += NT) { const int t = (o >> 7) & 127, s = o & 127; WL[W_S + o] = (bf16_t)(pk2(s <= t ? gws[o] : 0.f, 0.f) & 0xffffu); }
}

__device__ __forceinline__ void phase_init_rows(const Ctx& C) {
    const int tid_ = C.tidf(), lane_ = tid_ & 63, wave_ = __builtin_amdgcn_readfirstlane(tid_ >> 6); (void)lane_; (void)wave_;
    unsigned char* wsb = C.wsf();
    bf16_t* H = (bf16_t*)(wsb + O_H); float* RS = (float*)(wsb + O_RS);
    const float* xs = C.in(I_XS); const float* xp = C.in(I_XP);
    const int gw = C.bid * 8 + wave_, NGW = C.G * 8;
    for (int r0 = gw; r0 < TOT; r0 += 2 * NGW) {
        f32x4 v[2][4]; bool act[2];
#pragma unroll
        for (int k = 0; k < 2; ++k) { const int row = r0 + k * NGW; act[k] = row < TOT;
            const float* src = !act[k] ? nullptr : (row < 128 ? xs + (size_t)row * DM : (row < 256 ? nullptr : xp + (size_t)(row - 256) * DM));
#pragma unroll
            for (int i = 0; i < 2; ++i) { const int c = i * 512 + lane_ * 8;
                v[k][2 * i] = src ? *(const f32x4*)(src + c) : (f32x4){0.f, 0.f, 0.f, 0.f}; v[k][2 * i + 1] = src ? *(const f32x4*)(src + c + 4) : (f32x4){0.f, 0.f, 0.f, 0.f}; } }
#pragma unroll
        for (int k = 0; k < 2; ++k) { const int row = r0 + k * NGW; float ss = 0.f;
#pragma unroll
            for (int i = 0; i < 2; ++i) { const int c = i * 512 + lane_ * 8; const f32x4 a = v[k][2 * i], b = v[k][2 * i + 1];
                const float f[8] = {a.x, a.y, a.z, a.w, b.x, b.y, b.z, b.w};
#pragma unroll
                for (int e = 0; e < 8; ++e) ss += f[e] * f[e];
                if (act[k]) *(u32x4*)(H + (size_t)row * DM + c) = pack8(f); }
            ss = wave_sum(ss);
            if (lane_ == 0 && act[k]) RS[row] = rsqrtf(ss * (1.f / 1024.f) + EPS); }
    }
}
__device__ __forceinline__ void phase_rowpass(const Ctx& C, int rbeg, int rcnt, const bf16_t* F, int frow0, const float* gpost, float coef, bool final) {
    const int tid_ = C.tidf(), lane_ = tid_ & 63, wave_ = __builtin_amdgcn_readfirstlane(tid_ >> 6); (void)lane_; (void)wave_;
    unsigned char* wsb = C.wsf();
    bf16_t* H = (bf16_t*)(wsb + O_H); float* RS = (float*)(wsb + O_RS); float* SSQ = (float*)(wsb + O_SSQ);
    const int gw = C.bid * 8 + wave_, NGW = C.G * 8;
    float g[2][8];
#pragma unroll
    for (int i = 0; i < 2; ++i) { const int c = i * 512 + lane_ * 8; const f32x4 ga = *(const f32x4*)(gpost + c), gb = *(const f32x4*)(gpost + c + 4);
        g[i][0] = ga.x; g[i][1] = ga.y; g[i][2] = ga.z; g[i][3] = ga.w; g[i][4] = gb.x; g[i][5] = gb.y; g[i][6] = gb.z; g[i][7] = gb.w; }
    for (int rr = gw; rr < rcnt; rr += 2 * NGW) {
        u32x4 fw[2][2], hw[2][2]; float ssum[2]; bool act[2];
#pragma unroll
        for (int k = 0; k < 2; ++k) { const int row = rbeg + rr + k * NGW; act[k] = (rr + k * NGW) < rcnt;
            if (act[k]) {
                if (row < 128) { const float* sp = (const float*)(wsb + O_SSQS) + row * 64; ssum[k] = (sum16(sp) + sum16(sp + 16)) + (sum16(sp + 32) + sum16(sp + 48)); }
                else ssum[k] = sum16(SSQ + (size_t)row * 16);
#pragma unroll
                for (int i = 0; i < 2; ++i) { const int c = i * 512 + lane_ * 8; fw[k][i] = *(const u32x4*)(F + (size_t)(row - frow0) * DM + c); hw[k][i] = *(const u32x4*)(H + (size_t)row * DM + c); } }
            else { ssum[k] = 0.f;
#pragma unroll
                for (int i = 0; i < 2; ++i) { fw[k][i] = (u32x4){0u, 0u, 0u, 0u}; hw[k][i] = (u32x4){0u, 0u, 0u, 0u}; } } }
#pragma unroll
        for (int k = 0; k < 2; ++k) { const int row = rbeg + rr + k * NGW;
            const float sc = coef * rsqrtf(ssum[k] * (1.f / 1024.f) + EPS); float ss = 0.f;
            float* orow = nullptr;
            if (final && act[k]) { if (row < 128) orow = C.out + OUT_YS + (size_t)row * DM; else if (row >= 256) orow = C.out + OUT_YP + (size_t)(row - 256) * DM; }
#pragma unroll
            for (int i = 0; i < 2; ++i) { const int c = i * 512 + lane_ * 8; float f[8], h[8]; unpack8(fw[k][i], f); unpack8(hw[k][i], h);
#pragma unroll
                for (int e = 0; e < 8; ++e) { h[e] += sc * f[e] * g[i][e]; ss += h[e] * h[e]; }
                if (act[k]) *(u32x4*)(H + (size_t)row * DM + c) = pack8(h);
                if (orow) { *(f32x4*)(orow + c) = (f32x4){h[0], h[1], h[2], h[3]}; *(f32x4*)(orow + c + 4) = (f32x4){h[4], h[5], h[6], h[7]}; } }
            ss = wave_sum(ss);
            if (lane_ == 0 && act[k]) RS[row] = rsqrtf(ss * (1.f / 1024.f) + EPS); }
    }
}

struct MixBuf { bf16_t *xa, *z, *xbc, *u, *v, *gates, *xc, *zz, *yb, *st; float *dt, *decl; };
__device__ __forceinline__ MixBuf mix_bufs(const Ctx& C) {
    const MixLay L = mix_layout(C.ngf()); unsigned char* X = C.wsf() + O_X; MixBuf b;
    b.xa = (bf16_t*)(X + L.xa); b.z = (bf16_t*)(X + L.z); b.xbc = (bf16_t*)(X + L.xbc); b.u = (bf16_t*)(X + L.u); b.v = (bf16_t*)(X + L.v); b.gates = (bf16_t*)(X + L.gates);
    b.xc = (bf16_t*)(X + L.xc); b.zz = (bf16_t*)(X + L.zz); b.yb = (bf16_t*)(X + L.yb); b.st = (bf16_t*)(X + L.xbc); b.dt = (float*)(X + L.dt); b.decl = (float*)(X + L.decl); return b;
}
__device__ __forceinline__ void tok_block(const Grp& gr, int tb, int& r0, int& b, bool& first, bool& last, int& pos0, bool& samp) {
    if (tb < gr.nsc) { r0 = 16 * tb; b = tb; first = true; last = true; pos0 = 4096; samp = true; }
    else { const int q = tb - gr.nsc, bl = q >> 9, k = q & 511; r0 = gr.psoff + bl * SEQ + 16 * k; b = gr.g * gr.nbg + bl; first = (k == 0); last = (k == 511); pos0 = 16 * k; samp = false; }
}
__device__ __forceinline__ void phase_conv(const Ctx& C, const Grp& gr, int l) {
    const int tid_ = C.tidf(), lane_ = tid_ & 63, wave_ = __builtin_amdgcn_readfirstlane(tid_ >> 6); (void)lane_; (void)wave_;
    const MixBuf B = mix_bufs(C);
    const int ntb = gr.nsc + gr.nbg * 512;
    const int c0 = (tid_ & 255) * 8;
    const float* cw = C.in(I_CONVW) + (size_t)l * 4 * 2048; const float* cb = C.in(I_CONVB) + (size_t)l * 2048;
    float w[4][8], bias[8];
#pragma unroll
    for (int k = 0; k < 4; ++k) { const f32x4 a = *(const f32x4*)(cw + k * 2048 + c0), b2 = *(const f32x4*)(cw + k * 2048 + c0 + 4); w[k][0] = a.x; w[k][1] = a.y; w[k][2] = a.z; w[k][3] = a.w; w[k][4] = b2.x; w[k][5] = b2.y; w[k][6] = b2.z; w[k][7] = b2.w; }
    { const f32x4 a = *(const f32x4*)(cb + c0), b2 = *(const f32x4*)(cb + c0 + 4); bias[0] = a.x; bias[1] = a.y; bias[2] = a.z; bias[3] = a.w; bias[4] = b2.x; bias[5] = b2.y; bias[6] = b2.z; bias[7] = b2.w; }
    for (int it = C.bid; it * 2 < ntb; it += C.G) {
        const int tb = it * 2 + (tid_ >> 8); if (tb >= ntb) continue;
        int r0, b, pos0; bool first, last, samp; tok_block(gr, tb, r0, b, first, last, pos0, samp);
        float x1[8], x2[8], x3[8];
        if (first) {
            if (samp) { const float* hs = C.in(I_SCONV) + ((size_t)(l * 8 + b) * 3) * 2048 + c0;
#pragma unroll
                for (int e = 0; e < 8; ++e) { x3[e] = hs[e]; x2[e] = hs[2048 + e]; x1[e] = hs[4096 + e]; } }
            else {
#pragma unroll
                for (int e = 0; e < 8; ++e) { x1[e] = 0.f; x2[e] = 0.f; x3[e] = 0.f; } }
        } else {
            unpack8(*(const u32x4*)(B.xbc + (size_t)(r0 - 1) * 2048 + c0), x1); unpack8(*(const u32x4*)(B.xbc + (size_t)(r0 - 2) * 2048 + c0), x2); unpack8(*(const u32x4*)(B.xbc + (size_t)(r0 - 3) * 2048 + c0), x3);
        }
        float* cout = C.out + (samp ? OUT_CONVS : OUT_CONVP) + ((size_t)(l * 8 + b) * 3) * 2048 + c0;
        u32x4 xin[16];
#pragma unroll
        for (int t = 0; t < 16; ++t) xin[t] = *(const u32x4*)(B.xbc + (size_t)(r0 + t) * 2048 + c0);
#pragma unroll
        for (int t = 0; t < 16; ++t) {
            float x0[8], o[8]; unpack8(xin[t], x0);
#pragma unroll
            for (int e = 0; e < 8; ++e) { const float a = bias[e] + w[3][e] * x0[e] + w[2][e] * x1[e] + w[1][e] * x2[e] + w[0][e] * x3[e]; o[e] = silu_f(a); }
            *(u32x4*)(B.xc + (size_t)(r0 + t) * 2048 + c0) = pack8(o);
            if (last && t >= 13) { float* p = cout + (t - 13) * 2048; *(f32x4*)p = (f32x4){x0[0], x0[1], x0[2], x0[3]}; *(f32x4*)(p + 4) = (f32x4){x0[4], x0[5], x0[6], x0[7]}; }
#pragma unroll
            for (int e = 0; e < 8; ++e) { x3[e] = x2[e]; x2[e] = x1[e]; x1[e] = x0[e]; }
        }
    }
}
template <int W> __device__ __forceinline__ void pool_block(const Ctx& C, const MixBuf& B, int l, int r0, int b, bool first, bool last, int pos0, bool samp, int c0) {
    float v0[31], v1[31];
#pragma unroll
    for (int i = 0; i < 15; ++i) {
        if (first) { if (samp) { const float* hs = C.in(I_SPOOL) + ((size_t)(l * 8 + b) * 15 + i) * 512 + c0; v0[i] = hs[0]; v1[i] = hs[1]; } else { v0[i] = 0.f; v1[i] = 0.f; } }
        else { const unsigned wv = *(const unsigned*)(B.xa + (size_t)(r0 - 15 + i) * 512 + c0); v0[i] = bf_lo(wv); v1[i] = bf_hi(wv); }
    }
#pragma unroll
    for (int t = 0; t < 16; ++t) { const unsigned wv = *(const unsigned*)(B.xa + (size_t)(r0 + t) * 512 + c0); v0[15 + t] = bf_lo(wv); v1[15 + t] = bf_hi(wv); }
    float* pout = C.out + (samp ? OUT_POOLS : OUT_POOLP) + ((size_t)(l * 8 + b) * 15) * 512 + c0;
#pragma unroll
    for (int t = 0; t < 16; ++t) {
        float s0 = 0.f, s1 = 0.f;
#pragma unroll
        for (int i = 0; i < W; ++i) { s0 += v0[15 + t - i]; s1 += v1[15 + t - i]; }
        const int cn = (pos0 + t + 1) < W ? (pos0 + t + 1) : W; const float inv = 1.f / (float)cn;
        *(unsigned*)(B.zz + (size_t)(r0 + t) * 512 + c0) = pk2(s0 * inv - v0[15 + t], s1 * inv - v1[15 + t]);
        if (last && t >= 1) { pout[(t - 1) * 512] = v0[15 + t]; pout[(t - 1) * 512 + 1] = v1[15 + t]; }
    }
}
__device__ __forceinline__ void phase_pool(const Ctx& C, const Grp& gr, int l) {
    const int tid_ = C.tidf(), lane_ = tid_ & 63, wave_ = __builtin_amdgcn_readfirstlane(tid_ >> 6); (void)lane_; (void)wave_;
    const MixBuf B = mix_bufs(C);
    const int ntb = gr.nsc + gr.nbg * 512; const int c0 = (tid_ & 255) * 2; const int wsel = (wave_ & 3);
    for (int it = (C.bid + C.G / 3) % C.G; it * 2 < ntb; it += C.G) {
        const int tb = it * 2 + (tid_ >> 8); if (tb >= ntb) continue;
        int r0, b, pos0; bool first, last, samp; tok_block(gr, tb, r0, b, first, last, pos0, samp);
        if (wsel == 0) pool_block<2>(C, B, l, r0, b, first, last, pos0, samp, c0);
        else if (wsel == 1) pool_block<4>(C, B, l, r0, b, first, last, pos0, samp, c0);
        else if (wsel == 2) pool_block<8>(C, B, l, r0, b, first, last, pos0, samp, c0);
        else pool_block<16>(C, B, l, r0, b, first, last, pos0, samp, c0);
    }
}
constexpr int VN_STRIDE = 1056;
__device__ __forceinline__ void phase_gmlp(const Ctx& C, const Grp& gr, int l) {
    const int tid_ = C.tidf(), lane_ = tid_ & 63, wave_ = __builtin_amdgcn_readfirstlane(tid_ >> 6); (void)lane_; (void)wave_;
    const MixBuf B = mix_bufs(C);
    const int nun = gr.nsc + gr.nbg * 64;
    const bf16_t* WSb = (const bf16_t*)(C.wsf() + O_W) + W_S;
    const float* gng = C.in(I_GNG) + l * 512; const float* gnb = C.in(I_GNB) + l * 512; const float* gbs = C.in(I_GBS) + l * 512;
    const int lane = lane_, r = lane & 15, q = lane >> 4;
    for (int un = (C.bid + 2 * (C.G / 3)) % C.G; un < nun; un += C.G) {
        int r0, nvalid, b; bool samp;
        if (un < gr.nsc) { r0 = 16 * un; nvalid = 16; b = un; samp = true; }
        else { const int qq = un - gr.nsc, bl = qq >> 6, k = qq & 63; r0 = gr.psoff + bl * SEQ + 128 * k; nvalid = 128; b = 0; samp = false; }
        {
            const int s = tid_ >> 2, part = tid_ & 3; const bool valid = s < nvalid;
            u32x4 raw[16]; float sum = 0.f, sq = 0.f;
#pragma unroll
            for (int i = 0; i < 16; ++i) { const int col = (i * 4 + part) * 8; raw[i] = valid ? *(const u32x4*)(B.v + (size_t)(r0 + s) * 512 + col) : (u32x4){0u, 0u, 0u, 0u};
                float f[8]; unpack8(raw[i], f);
#pragma unroll
                for (int e = 0; e < 8; ++e) { sum += f[e]; sq += f[e] * f[e]; } }
            sum += __shfl_xor(sum, 1); sum += __shfl_xor(sum, 2); sq += __shfl_xor(sq, 1); sq += __shfl_xor(sq, 2);
            const float mu = sum * (1.f / 512.f); const float var = sq * (1.f / 512.f) - mu * mu; const float rstd = rsqrtf((var > 0.f ? var : 0.f) + EPS);
            float* vout = C.out + OUT_VS + ((size_t)(l * 8 + b) * 16 + s) * 512;
#pragma unroll
            for (int i = 0; i < 16; ++i) { const int col = (i * 4 + part) * 8; float f[8]; unpack8(raw[i], f);
                const f32x4 ga = *(const f32x4*)(gng + col), gb2 = *(const f32x4*)(gng + col + 4), ba = *(const f32x4*)(gnb + col), bb = *(const f32x4*)(gnb + col + 4);
                const float g[8] = {ga.x, ga.y, ga.z, ga.w, gb2.x, gb2.y, gb2.z, gb2.w}, bt[8] = {ba.x, ba.y, ba.z, ba.w, bb.x, bb.y, bb.z, bb.w};
#pragma unroll
                for (int e = 0; e < 8; ++e) f[e] = valid ? (f[e] - mu) * rstd * g[e] + bt[e] : 0.f;
                *(LAS u32x4*)(C.lds + s * VN_STRIDE + col * 2) = pack8(f);
                if (samp && valid) { *(f32x4*)(vout + col) = (f32x4){f[0], f[1], f[2], f[3]}; *(f32x4*)(vout + col + 4) = (f32x4){f[4], f[5], f[6], f[7]}; } }
        }
        __syncthreads();
        {
            const int h = wave_ >> 1, th = wave_ & 1; const int nkb_full = (th + 1) * 2, nkb_v = (nvalid + 31) >> 5; const int nkb = (th * 64 >= nvalid) ? 0 : (nkb_full < nkb_v ? nkb_full : nkb_v);
#pragma unroll 1
            for (int chh = 0; chh < 2; ++chh) {
                f32x4 acc[4][4];
#pragma unroll
                for (int a = 0; a < 4; ++a)
#pragma unroll
                    for (int c = 0; c < 4; ++c) acc[a][c] = (f32x4){0.f, 0.f, 0.f, 0.f};
#pragma unroll 1
                for (int kb = 0; kb < nkb; ++kb) {
                    s16x8 Q[4], P[4];
#pragma unroll
                    for (int tt = 0; tt < 4; ++tt) Q[tt] = *(const s16x8*)(WSb + ((size_t)h * 128 + (th * 4 + tt) * 16 + r) * 128 + kb * 32 + q * 8);
#pragma unroll
                    for (int ct = 0; ct < 4; ++ct) P[ct] = tr_frag(C.lds, VN_STRIDE, kb * 32, h * 128 + chh * 64 + ct * 16, lane);
#pragma unroll
                    for (int ct = 0; ct < 4; ++ct)
#pragma unroll
                        for (int tt = 0; tt < 4; ++tt) acc[ct][tt] = MFMA16(P[ct], Q[tt], acc[ct][tt]);
                }
                u32x2 uq[4][4]; float bsq[4];
#pragma unroll
                for (int tt = 0; tt < 4; ++tt) { const int t = (th * 4 + tt) * 16 + r; const bool tv = t < nvalid; bsq[tt] = tv ? gbs[h * 128 + t] : 0.f;
#pragma unroll
                    for (int ct = 0; ct < 4; ++ct) uq[tt][ct] = tv ? *(const u32x2*)(B.u + (size_t)(r0 + t) * 512 + h * 128 + chh * 64 + ct * 16 + q * 4) : (u32x2){0u, 0u}; }
#pragma unroll
                for (int tt = 0; tt < 4; ++tt) { const int t = (th * 4 + tt) * 16 + r;
                    if (t < nvalid) { const float bsv = bsq[tt];
#pragma unroll
                        for (int ct = 0; ct < 4; ++ct) { const int c = h * 128 + chh * 64 + ct * 16 + q * 4; bf16_t* up = B.u + (size_t)(r0 + t) * 512 + c;
                            const u32x2 uw = uq[tt][ct]; u32x2 o;
                            o.x = pk2(bf_lo(uw.x) * (acc[ct][tt][0] + bsv), bf_hi(uw.x) * (acc[ct][tt][1] + bsv)); o.y = pk2(bf_lo(uw.y) * (acc[ct][tt][2] + bsv), bf_hi(uw.y) * (acc[ct][tt][3] + bsv));
                            *(u32x2*)up = o; } } }
            }
        }
        __syncthreads();
    }
}

constexpr int CH = 128;
__device__ __forceinline__ void ssd_chunk(const Grp& gr, int ci, int& r0, int& nvalid) {
    if (ci < gr.nsc) { r0 = 16 * ci; nvalid = 16; } else { const int qq = ci - gr.nsc, bl = qq >> 6, c = qq & 63; r0 = gr.psoff + bl * SEQ + CH * c; nvalid = CH; }
}
constexpr int XS_STRIDE = 544, BC_STRIDE = 288, BC2_STRIDE = 272;
__device__ __forceinline__ float scan64(float v, int lane) {
#pragma unroll
    for (int o = 1; o < 64; o <<= 1) { const float t = __shfl_up(v, o); if (lane >= o) v += t; }
    return v;
}
__device__ __forceinline__ void chunk_cum128(float v1, float v2, int lane, float& c1, float& c2, float& last) {
    c1 = scan64(v1, lane); const float t1 = __shfl(c1, 63); c2 = scan64(v2, lane) + t1; last = __shfl(c2, 63);
}
__device__ __forceinline__ void phase_ssd_a1(const Ctx& C, const Grp& gr, int l) {
    const int tid_ = C.tidf(), lane_ = tid_ & 63, wave_ = __builtin_amdgcn_readfirstlane(tid_ >> 6);
    const MixBuf B = mix_bufs(C);
    const int nch = gr.nsc + gr.nbg * 64, nun = nch * 4;
    const float* alog = C.in(I_ALOG) + l * 16;
    LAS unsigned char* XW = C.lds; LAS unsigned char* BS = C.lds + CH * XS_STRIDE; LAS float* wS = (LAS float*)(C.lds + CH * XS_STRIDE + CH * BC_STRIDE);
    const int lane = lane_, r = lane & 15, q = lane >> 4;
    const int nit = ((nch + 7) >> 3) * 32;
    for (int it = C.bid; it < nit; it += C.G) {
        const int ci = (it & 7) + 8 * ((it >> 3) >> 2), hg = (it >> 3) & 3; if (ci >= nch) continue;
        (void)nun; int r0, nvalid; ssd_chunk(gr, ci, r0, nvalid);
        const int nkb = (nvalid + 31) >> 5;
        u32x4 gx[8], gb[4];
        { const int ll = tid_ >> 2, quad = tid_ & 3; const bool valid = ll < nvalid;
#pragma unroll
            for (int i = 0; i < 8; ++i) gx[i] = valid ? *(const u32x4*)(B.xc + (size_t)(r0 + ll) * 2048 + hg * 256 + (i * 4 + quad) * 8) : (u32x4){0u, 0u, 0u, 0u};
#pragma unroll
            for (int j = 0; j < 4; ++j) { const int id = tid_ + j * 512, l2 = id >> 4, cb = id & 15;
                gb[j] = l2 < nvalid ? *(const u32x4*)(B.xc + (size_t)(r0 + l2) * 2048 + 1024 + hg * 128 + cb * 8) : (u32x4){0u, 0u, 0u, 0u}; } }
        if (wave_ < 4) { const int h = hg * 4 + wave_;
            const float d1 = lane < nvalid ? B.dt[(size_t)(r0 + lane) * 16 + h] : 0.f, d2 = 64 + lane < nvalid ? B.dt[(size_t)(r0 + 64 + lane) * 16 + h] : 0.f; const float a = -__expf(alog[h]);
            float c1, c2, last; chunk_cum128(d1 * a, d2 * a, lane, c1, c2, last);
            wS[wave_ * CH + lane] = __expf(last - c1) * d1; wS[wave_ * CH + 64 + lane] = __expf(last - c2) * d2;
            if (lane == 0) B.decl[ci * 16 + h] = __expf(last); }
        __syncthreads();
        { const int ll = tid_ >> 2, quad = tid_ & 3; const bool valid = ll < nvalid;
#pragma unroll
            for (int i = 0; i < 8; ++i) { const int ch = (i * 4 + quad) * 8; float f[8];
                if (valid) { unpack8(gx[i], f); const float wv = wS[(i >> 1) * CH + ll];
#pragma unroll
                    for (int e = 0; e < 8; ++e) f[e] *= wv; }
                else {
#pragma unroll
                    for (int e = 0; e < 8; ++e) f[e] = 0.f; }
                *(LAS u32x4*)(XW + ll * XS_STRIDE + ch * 2) = pack8(f); }
#pragma unroll
            for (int j = 0; j < 4; ++j) { const int id = tid_ + j * 512, l2 = id >> 4, cb = id & 15;
                *(LAS u32x4*)(BS + l2 * BC_STRIDE + cb * 16) = gb[j]; } }
        __syncthreads();
        { const int n0 = wave_ * 16; s16x8 P[4];
#pragma unroll
            for (int kb = 0; kb < 4; ++kb) P[kb] = tr_frag(BS, BC_STRIDE, kb * 32, n0, lane);
#pragma unroll
            for (int hh = 0; hh < 4; ++hh)
#pragma unroll
                for (int pt = 0; pt < 4; ++pt) { f32x4 acc = (f32x4){0.f, 0.f, 0.f, 0.f};
#pragma unroll
                    for (int kb = 0; kb < 4; ++kb) if (kb < nkb) { const s16x8 Q = tr_frag(XW, XS_STRIDE, kb * 32, hh * 64 + pt * 16, lane); acc = MFMA16(P[kb], Q, acc); }
                    u32x2 o; o.x = pk2(acc[0], acc[1]); o.y = pk2(acc[2], acc[3]);
                    *(u32x2*)(B.st + (((size_t)ci * 16 + hg * 4 + hh) * 64 + pt * 16 + r) * 128 + n0 + 4 * q) = o; } }
        __syncthreads();
    }
}
__device__ __forceinline__ void phase_ssd_a2(const Ctx& C, const Grp& gr, int l) {
    const int tid_ = C.tidf();
    const MixBuf B = mix_bufs(C);
    const int nseq = gr.nbg + gr.nsc; const int gt = C.bid * 512 + tid_, NT = C.G * 512;
    for (int it = gt; it < nseq * 32768; it += NT) {
        const int sq = it >> 15, e4 = (it & 32767) * 4, h = e4 >> 13;
        if (sq < gr.nbg) {
            const int cbase = gr.nsc + sq * 64; const int b = gr.g * gr.nbg + sq;
            float s[4] = {0.f, 0.f, 0.f, 0.f};
            u32x2 sv[16], sn[16]; float dc[16], dn[16];
#pragma unroll
            for (int j = 0; j < 16; ++j) { sv[j] = *(const u32x2*)(B.st + (size_t)(cbase + j) * 131072 + e4); dc[j] = B.decl[(cbase + j) * 16 + h]; }
#pragma unroll 1
            for (int c0 = 0; c0 < 64; c0 += 16) {
                const bool more = c0 + 16 < 64;
#pragma unroll
                for (int j = 0; j < 16; ++j) { sn[j] = more ? *(const u32x2*)(B.st + (size_t)(cbase + c0 + 16 + j) * 131072 + e4) : (u32x2){0u, 0u}; dn[j] = more ? B.decl[(cbase + c0 + 16 + j) * 16 + h] : 0.f; }
#pragma unroll
                for (int j = 0; j < 16; ++j) { u32x2 o; o.x = pk2(s[0], s[1]); o.y = pk2(s[2], s[3]); *(u32x2*)(B.st + (size_t)(cbase + c0 + j) * 131072 + e4) = o;
                    s[0] = s[0] * dc[j] + bf_lo(sv[j].x); s[1] = s[1] * dc[j] + bf_hi(sv[j].x); s[2] = s[2] * dc[j] + bf_lo(sv[j].y); s[3] = s[3] * dc[j] + bf_hi(sv[j].y); }
#pragma unroll
                for (int j = 0; j < 16; ++j) { sv[j] = sn[j]; dc[j] = dn[j]; }
            }
            *(f32x4*)(C.out + OUT_SSMP + ((size_t)(l * 8 + b)) * 131072 + e4) = (f32x4){s[0], s[1], s[2], s[3]};
        } else {
            const int b = sq - gr.nbg; const f32x4 s0 = *(const f32x4*)(C.in(I_SSSM) + ((size_t)(l * 8 + b)) * 131072 + e4);
            bf16_t* sp = B.st + (size_t)b * 131072 + e4; const u32x2 sv = *(const u32x2*)sp; const float dc = B.decl[b * 16 + h];
            u32x2 o; o.x = pk2(s0.x, s0.y); o.y = pk2(s0.z, s0.w); *(u32x2*)sp = o;
            *(f32x4*)(C.out + OUT_SSMS + ((size_t)(l * 8 + b)) * 131072 + e4) = (f32x4){s0.x * dc + bf_lo(sv.x), s0.y * dc + bf_hi(sv.x), s0.z * dc + bf_lo(sv.y), s0.w * dc + bf_hi(sv.y)};
        }
    }
}
__device__ __forceinline__ void phase_ssd_b(const Ctx& C, const Grp& gr, int l) {
    const int tid_ = C.tidf(), lane_ = tid_ & 63, wave_ = __builtin_amdgcn_readfirstlane(tid_ >> 6);
    const MixBuf B = mix_bufs(C);
    const int nch = gr.nsc + gr.nbg * 64, nun = nch * 4;
    const float* alog = C.in(I_ALOG) + l * 16; const float* dsk = C.in(I_SSMD) + l * 16; float* SSQY = (float*)(C.wsf() + O_SSQY) + (size_t)gr.row0 * 16;
    LAS unsigned char* CS = C.lds; LAS unsigned char* BS = C.lds + CH * BC2_STRIDE; LAS unsigned char* XS = C.lds + 2 * CH * BC2_STRIDE;
    LAS float* cumS = (LAS float*)(C.lds + 2 * CH * BC2_STRIDE + CH * XS_STRIDE); LAS float* dtS = cumS + 4 * CH;
    const int lane = lane_, r = lane & 15, q = lane >> 4;
    const int nit = ((nch + 7) >> 3) * 32;
    for (int it = C.bid; it < nit; it += C.G) {
        const int ci = (it & 7) + 8 * ((it >> 3) >> 2), hg = (it >> 3) & 3; if (ci >= nch) continue;
        (void)nun; int r0, nvalid; ssd_chunk(gr, ci, r0, nvalid);
        const int nlt = (nvalid + 15) >> 4;
        if (wave_ < 4) { const int h = hg * 4 + wave_;
            const float d1 = lane < nvalid ? B.dt[(size_t)(r0 + lane) * 16 + h] : 0.f, d2 = 64 + lane < nvalid ? B.dt[(size_t)(r0 + 64 + lane) * 16 + h] : 0.f; const float a = -__expf(alog[h]);
            float c1, c2, last; chunk_cum128(d1 * a, d2 * a, lane, c1, c2, last);
            cumS[wave_ * CH + lane] = c1; cumS[wave_ * CH + 64 + lane] = c2; dtS[wave_ * CH + lane] = d1; dtS[wave_ * CH + 64 + lane] = d2; }
        { const int ll = tid_ >> 2, quad = tid_ & 3; const bool valid = ll < nvalid;
#pragma unroll
            for (int i = 0; i < 8; ++i) { const int ch = (i * 4 + quad) * 8;
                const u32x4 wv = valid ? *(const u32x4*)(B.xc + (size_t)(r0 + ll) * 2048 + hg * 256 + ch) : (u32x4){0u, 0u, 0u, 0u};
                *(LAS u32x4*)(XS + ll * XS_STRIDE + ch * 2) = wv; }
#pragma unroll
            for (int j = 0; j < 4; ++j) { const int id = tid_ + j * 512, l2 = id >> 4, cb = id & 15; const bool v2 = l2 < nvalid;
                const u32x4 bv = v2 ? *(const u32x4*)(B.xc + (size_t)(r0 + l2) * 2048 + 1024 + hg * 128 + cb * 8) : (u32x4){0u, 0u, 0u, 0u};
                const u32x4 cv = v2 ? *(const u32x4*)(B.xc + (size_t)(r0 + l2) * 2048 + 1536 + hg * 128 + cb * 8) : (u32x4){0u, 0u, 0u, 0u};
                *(LAS u32x4*)(BS + l2 * BC2_STRIDE + cb * 16) = bv; *(LAS u32x4*)(CS + l2 * BC2_STRIDE + cb * 16) = cv; } }
        __syncthreads();
        { const int hh = wave_ >> 1, lh = wave_ & 1, h = hg * 4 + hh; const float dh = dsk[h];
#pragma unroll 1
          for (int ps = 0; ps < 2; ++ps) {
            const int lt0 = lh * 4 + ps * 2;
            if (lt0 >= nlt) continue;
            const int nk2 = (lt0 >> 1) + 1;
            u32x2 zq[2][4];
#pragma unroll
            for (int i = 0; i < 2; ++i) { const int lrow = (lt0 + i) * 16 + r;
#pragma unroll
                for (int pt = 0; pt < 4; ++pt) zq[i][pt] = lrow < nvalid ? *(const u32x2*)(B.z + (size_t)(r0 + lrow) * 1024 + hg * 256 + hh * 64 + pt * 16 + 4 * q) : (u32x2){0u, 0u}; }
            s16x8 Cq[2][4];
#pragma unroll
            for (int i = 0; i < 2; ++i)
#pragma unroll
                for (int kb = 0; kb < 4; ++kb) Cq[i][kb] = *(const LAS s16x8*)(CS + ((lt0 + i) * 16 + r) * BC2_STRIDE + kb * 64 + q * 16);
            s16x8 Mq[2][4];
#pragma unroll
            for (int i = 0; i < 2; ++i) { const int lrow = (lt0 + i) * 16 + r; const float cl = cumS[hh * CH + lrow];
#pragma unroll
                for (int k2 = 0; k2 < 4; ++k2) { unsigned pw[4] = {0u, 0u, 0u, 0u};
                    if (k2 < nk2) {
#pragma unroll
                    for (int s2 = 0; s2 < 2; ++s2) { const int st = k2 * 2 + s2; f32x4 cb = (f32x4){0.f, 0.f, 0.f, 0.f};
#pragma unroll
                        for (int kb = 0; kb < 4; ++kb) { const s16x8 Pb = *(const LAS s16x8*)(BS + (st * 16 + r) * BC2_STRIDE + kb * 64 + q * 16); cb = MFMA16(Pb, Cq[i][kb], cb); }
                        const f32x4 cs4 = *(const LAS f32x4*)(cumS + hh * CH + st * 16 + 4 * q), dt4 = *(const LAS f32x4*)(dtS + hh * CH + st * 16 + 4 * q);
                        float mv[4];
#pragma unroll
                        for (int jj = 0; jj < 4; ++jj) { const int sidx = st * 16 + 4 * q + jj; mv[jj] = sidx <= lrow ? cb[jj] * __expf(cl - cs4[jj]) * dt4[jj] : 0.f; }
                        pw[s2 * 2] = pk2(mv[0], mv[1]); pw[s2 * 2 + 1] = pk2(mv[2], mv[3]); } }
                    const u32x4 t4 = (u32x4){pw[0], pw[1], pw[2], pw[3]}; Mq[i][k2] = __builtin_bit_cast(s16x8, t4); } }
            f32x4 acc[4][2];
#pragma unroll
            for (int pt = 0; pt < 4; ++pt)
#pragma unroll
                for (int i = 0; i < 2; ++i) acc[pt][i] = (f32x4){0.f, 0.f, 0.f, 0.f};
#pragma unroll
            for (int pt = 0; pt < 4; ++pt)
#pragma unroll
                for (int kb = 0; kb < 4; ++kb) { const s16x8 Ps = *(const s16x8*)(B.st + (((size_t)ci * 16 + h) * 64 + pt * 16 + r) * 128 + kb * 32 + q * 8);
#pragma unroll
                    for (int i = 0; i < 2; ++i) acc[pt][i] = MFMA16(Ps, Cq[i][kb], acc[pt][i]); }
#pragma unroll
            for (int i = 0; i < 2; ++i) { const float ec = __expf(cumS[hh * CH + (lt0 + i) * 16 + r]);
#pragma unroll
                for (int pt = 0; pt < 4; ++pt) acc[pt][i] *= ec; }
#pragma unroll
            for (int pt = 0; pt < 4; ++pt)
#pragma unroll
                for (int k2 = 0; k2 < 4; ++k2) if (k2 < nk2) { const s16x8 Px = tr_frag_perm(XS, XS_STRIDE, k2 * 32, hh * 64 + pt * 16, lane);
#pragma unroll
                    for (int i = 0; i < 2; ++i) acc[pt][i] = MFMA16(Px, Mq[i][k2], acc[pt][i]); }
#pragma unroll
            for (int i = 0; i < 2; ++i) { const int lrow = (lt0 + i) * 16 + r; float ss = 0.f; const bool valid = lrow < nvalid;
#pragma unroll
                for (int pt = 0; pt < 4; ++pt) { const int chl = hh * 64 + pt * 16 + 4 * q;
                    const u32x2 xw = *(const LAS u32x2*)(XS + lrow * XS_STRIDE + chl * 2);
                    const u32x2 zw = zq[i][pt];
                    const float y0 = (acc[pt][i][0] + dh * bf_lo(xw.x)) * bf_lo(zw.x), y1 = (acc[pt][i][1] + dh * bf_hi(xw.x)) * bf_hi(zw.x),
                                y2 = (acc[pt][i][2] + dh * bf_lo(xw.y)) * bf_lo(zw.y), y3 = (acc[pt][i][3] + dh * bf_hi(xw.y)) * bf_hi(zw.y);
                    ss += y0 * y0 + y1 * y1 + y2 * y2 + y3 * y3;
                    if (valid) { u32x2 o; o.x = pk2(y0, y1); o.y = pk2(y2, y3); *(u32x2*)(B.yb + (size_t)(r0 + lrow) * 1024 + hg * 256 + chl) = o; } }
                ss += __shfl_xor(ss, 16); ss += __shfl_xor(ss, 32);
                if (q == 0 && valid) SSQY[(size_t)(r0 + lrow) * 16 + h] = ss; }
          }
        }
        __syncthreads();
    }
}

__global__ void __launch_bounds__(512, 2) mega_fwd(Params prm) {
    extern __shared__ __attribute__((aligned(16))) unsigned char lds_raw[];
    cg::grid_group grid = cg::this_grid();
    Ctx C; C.lds = (LAS unsigned char*)lds_raw; C.tid = threadIdx.x; C.lane = C.tid & 63; C.wave = __builtin_amdgcn_readfirstlane(C.tid >> 6); C.bid = blockIdx.x; C.G = gridDim.x;
    C.out = prm.out; C.ws0 = prm.ws; C.ng = prm.ng;
    if (C.tid < 32) ((LAS unsigned long long*)(C.lds + TAB_OFF))[C.tid] = (unsigned long long)prm.in[C.tid];
    if (C.tid < 2) ((volatile LAS unsigned*)(C.lds + TAB_OFF + 256))[C.tid] = 0u;
    __syncthreads();
    if (C.bid == 0) { unsigned* bw = (unsigned*)(prm.ws + O_BAR); for (int i = C.tid; i < XCD_BAR_WORDS; i += 512) bw[i] = 0u; }
    asm volatile("s_waitcnt vmcnt(0) lgkmcnt(0)" ::: "memory"); grid.sync();
    const XcdBarrier xbar = xcd_barrier_post((unsigned*)(prm.ws + O_BAR), (volatile LAS unsigned*)(C.lds + TAB_OFF + 256));
#define GSYNC() xcd_barrier(xbar)
#define GSYNC_CG() do { asm volatile("s_waitcnt vmcnt(0) lgkmcnt(0)" ::: "memory"); grid.sync(); } while (0)
#define GEMM_RUN(EPI, Aptr, Bptr, Mrows, Ncols, Kdim, ...) do { pg8::Gemm g_{(const bf16_t*)(Aptr), (const bf16_t*)(Bptr), (Mrows), (Ncols), (Kdim)}; pg8::StaticOrder S_; S_.init((Mrows), (Ncols), C.G, C.bid); \
        EPI E_{__VA_ARGS__}; pg8::gemm_phase<EPI, pg8::StaticOrder, true, true>(C.lds, g_, S_, E_); } while (0)
    phase_init_rows(C);
#pragma unroll 1
    for (int l = 0; l < DEPTH; ++l) {
        phase_weights(C, l);
        GSYNC();
        { unsigned char* w = C.wsf(); GEMM_RUN(EpiSwiglu, (bf16_t*)(w + O_H) + (size_t)256 * DM, (bf16_t*)(w + O_W) + W_GU1, 65536, NGU, DM, (bf16_t*)(w + O_X + X_ACT) + (size_t)256 * DFF, (const float*)(w + O_RS) + 256); }
        { unsigned char* w = C.wsf(); skinny_swiglu(C, (const bf16_t*)(w + O_H), (const bf16_t*)(w + O_W) + W_GU1, (const float*)(w + O_RS), (bf16_t*)(w + O_X + X_ACT)); }
        GSYNC();
        { unsigned char* w = C.wsf(); GEMM_RUN(EpiStoreSsq, (bf16_t*)(w + O_X + X_ACT) + (size_t)256 * DFF, (bf16_t*)(w + O_W) + W_D1, 65536, DM, DFF, (bf16_t*)(w + O_X + X_F) + (size_t)256 * DM, (float*)(w + O_SSQ) + 256 * 16); }
        { unsigned char* w = C.wsf(); const SkStoreSsq E{(bf16_t*)(w + O_X + X_F), (float*)(w + O_SSQS)}; skinny_gemm(C, (const bf16_t*)(w + O_X + X_ACT), (const bf16_t*)(w + O_W) + W_D1, DFF, E); }
        GSYNC();
        { unsigned char* w = C.wsf(); phase_rowpass(C, 0, TOT, (const bf16_t*)(w + O_X + X_F), 0, C.in(I_F1POST) + l * DM, 0.5f, false); }
        GSYNC();
#pragma unroll 1
        for (int gi = 0; gi < (DBG == 1 ? 0 : C.ng); ++gi) {
            const Grp gr = make_grp(gi, C.ng);
            { unsigned char* w = C.wsf(); const MixBuf MB = mix_bufs(C); GEMM_RUN(EpiProj, (bf16_t*)(w + O_H) + (size_t)gr.row0 * DM, (bf16_t*)(w + O_W) + W_IN, gr.nrows, NIN, DM, MB.xa, MB.z, MB.xbc, MB.u, MB.v, MB.gates, MB.dt, (const float*)(w + O_RS) + gr.row0, C.in(I_DTB) + l * 16); }
            GSYNC();
            phase_conv(C, gr, l);
            phase_pool(C, gr, l);
            phase_gmlp(C, gr, l);
            GSYNC();
            if (DBG != 2) { phase_ssd_a1(C, gr, l);
            GSYNC();
            phase_ssd_a2(C, gr, l);
            GSYNC();
            phase_ssd_b(C, gr, l);
            GSYNC(); }
            { unsigned char* w = C.wsf(); const MixBuf MB = mix_bufs(C); const size_t po = gr.psoff; GEMM_RUN(EpiMerge<0>, MB.zz + po * 512, (bf16_t*)(w + O_W) + W_A, gr.tg, DM, 512, MB.z + po * DM, MB.gates + po * 3072, nullptr);
              if (gr.nsc) { const SkMerge<0> E{MB.z, MB.gates, nullptr}; skinny_gemm(C, MB.zz, (const bf16_t*)(w + O_W) + W_A, 512, E); } }
            __syncthreads();
            if (DBG != 2 && DBG != 3) { unsigned char* w = C.wsf(); const MixBuf MB = mix_bufs(C); const size_t po = gr.psoff; GEMM_RUN(EpiMerge<1>, MB.yb + po * DM, (bf16_t*)(w + O_W) + W_B, gr.tg, DM, DM, MB.z + po * DM, MB.gates + po * 3072 + 1024, (const float*)(w + O_SSQY) + ((size_t)gr.row0 + po) * 16);
              if (gr.nsc) { const SkMerge<1> E{MB.z, MB.gates + 1024, (const float*)(w + O_SSQY)}; skinny_gemm(C, MB.yb, (const bf16_t*)(w + O_W) + W_B, DM, E); } }
            __syncthreads();
            { unsigned char* w = C.wsf(); const MixBuf MB = mix_bufs(C); const size_t po = gr.psoff; GEMM_RUN(EpiMerge<2>, MB.u + po * 512, (bf16_t*)(w + O_W) + W_C, gr.tg, DM, 512, MB.z + po * DM, MB.gates + po * 3072 + 2048, nullptr);
              if (gr.nsc) { const SkMerge<2> E{MB.z, MB.gates + 2048, nullptr}; skinny_gemm(C, MB.u, (const bf16_t*)(w + O_W) + W_C, 512, E); } }
            GSYNC();
            { unsigned char* w = C.wsf(); const MixBuf MB = mix_bufs(C); const size_t po = gr.psoff; GEMM_RUN(EpiStoreSsq, MB.z + po * DM, (bf16_t*)(w + O_W) + W_O, gr.tg, DM, DM, MB.yb + po * DM, (float*)(w + O_SSQ) + ((size_t)gr.row0 + po) * 16);
              if (gr.nsc) { const SkStoreSsq E{MB.yb, (float*)(w + O_SSQS)}; skinny_gemm(C, MB.z, (const bf16_t*)(w + O_W) + W_O, DM, E); } }
            GSYNC();
            { const MixBuf MB = mix_bufs(C); phase_rowpass(C, gr.row0, gr.nrows, MB.yb, gr.row0, C.in(I_MPOST) + l * DM, 1.0f, false); }
            GSYNC();
        }
        { unsigned char* w = C.wsf(); GEMM_RUN(EpiSwiglu, (bf16_t*)(w + O_H) + (size_t)256 * DM, (bf16_t*)(w + O_W) + W_GU2, 65536, NGU, DM, (bf16_t*)(w + O_X + X_ACT) + (size_t)256 * DFF, (const float*)(w + O_RS) + 256); }
        { unsigned char* w = C.wsf(); skinny_swiglu(C, (const bf16_t*)(w + O_H), (const bf16_t*)(w + O_W) + W_GU2, (const float*)(w + O_RS), (bf16_t*)(w + O_X + X_ACT)); }
        GSYNC();
        { unsigned char* w = C.wsf(); GEMM_RUN(EpiStoreSsq, (bf16_t*)(w + O_X + X_ACT) + (size_t)256 * DFF, (bf16_t*)(w + O_W) + W_D2, 65536, DM, DFF, (bf16_t*)(w + O_X + X_F) + (size_t)256 * DM, (float*)(w + O_SSQ) + 256 * 16); }
        { unsigned char* w = C.wsf(); const SkStoreSsq E{(bf16_t*)(w + O_X + X_F), (float*)(w + O_SSQS)}; skinny_gemm(C, (const bf16_t*)(w + O_X + X_ACT), (const bf16_t*)(w + O_W) + W_D2, DFF, E); }
        GSYNC();
        { unsigned char* w = C.wsf(); phase_rowpass(C, 0, TOT, (const bf16_t*)(w + O_X + X_F), 0, C.in(I_F2POST) + l * DM, 0.5f, l == DEPTH - 1); }
        GSYNC();
    }
}

extern "C" void kernel_launch(void* const* d_in, const int* in_sizes, int n_in, void* d_out, int out_size, void* d_ws, size_t ws_size, hipStream_t stream) {
    static int grid = 0, ng = 0;
    if (grid == 0) {
        int dev = 0, cus = 0, per_cu = 0;
        hipGetDevice(&dev); hipDeviceGetAttribute(&cus, hipDeviceAttributeMultiprocessorCount, dev);
        if (hipFuncSetAttribute((const void*)mega_fwd, hipFuncAttributeMaxDynamicSharedMemorySize, LDS_BYTES) != hipSuccess) { fprintf(stderr, "hipFuncSetAttribute failed\n"); grid = -1; return; }
        hipOccupancyMaxActiveBlocksPerMultiprocessor(&per_cu, (const void*)mega_fwd, 512, LDS_BYTES);
        (void)hipGetLastError();
        if (per_cu < 1) { fprintf(stderr, "occupancy query says %d blocks per CU\n", per_cu); per_cu = 1; }
        grid = cus;
        ng = 0;
        for (int c = 2; c <= 8; c *= 2) { const MixLay m = mix_layout(c); const size_t xe = m.end > X_FFN_END ? m.end : X_FFN_END; if (O_X + xe <= ws_size) { ng = c; break; } }
        if (ng == 0 || n_in != 32) { fprintf(stderr, "workspace too small (%zu) or unexpected inputs (%d)\n", ws_size, n_in); grid = -1; return; }
    }
    if (grid < 0) return;
    Params p{};
    for (int i = 0; i < 32; ++i) p.in[i] = (const float*)d_in[i];
    p.out = (float*)d_out; p.ws = (unsigned char*)d_ws; p.ng = ng; p.pad = 0;
    void* args[] = {&p};
    hipError_t e = hipLaunchCooperativeKernel((const void*)mega_fwd, dim3(grid), dim3(512), args, LDS_BYTES, stream);
    if (e != hipSuccess) fprintf(stderr, "cooperative launch failed: %s (grid %d)\n", hipGetErrorString(e), grid);
}
```
